# Optimizing an MI355X kernel written in HIP

```python
import jax, jax.numpy as jnp
from jax import lax
import numpy as np

D_MODEL = 1024
BATCH = 4
SEQ = 8192
DEPTH = 1
DEC_BATCH = 8
DEC_SEQ = 32
PAST_LEN = 4096

CHUNK = 64
N_META = 16
Q_BLOCK = 128
META_PAD = Q_BLOCK - N_META
RET_HEADS = 4
RET_QK_DIM = D_MODEL // 8
RET_V_DIM = D_MODEL // 4
RET_QK_W = RET_HEADS * RET_QK_DIM
RET_V_W = RET_HEADS * RET_V_DIM
FOX_HEADS = 8
FOX_DIM = D_MODEL // 8
FOX_W = FOX_HEADS * FOX_DIM
D_FF = 4 * D_MODEL
ROPE_BASE = 10000.0
EPS = 1e-6
NEG_INF = -1e30
IN_SIZES = (RET_QK_W, RET_QK_W, RET_V_W, RET_V_W, FOX_W, FOX_W, FOX_W, FOX_HEADS, D_MODEL, D_MODEL)
IN_W = 2 * RET_QK_W + 2 * RET_V_W + 3 * FOX_W + FOX_HEADS + 2 * D_MODEL

kernel_name = "hybrid_retention_fox_stream_step"


def rmsnorm(x, g):
    xf = x.astype(jnp.float32)
    y = xf * lax.rsqrt(jnp.mean(xf * xf, axis=-1, keepdims=True) + EPS)
    return (y * g.astype(jnp.float32)).astype(x.dtype)


def rotary(x, pos):
    half = x.shape[-1] // 2
    inv = ROPE_BASE ** (-jnp.arange(half, dtype=jnp.float32) / half)
    ang = pos.astype(jnp.float32)[:, None] * inv[None, :]
    cos = jnp.cos(ang)[:, None, :]
    sin = jnp.sin(ang)[:, None, :]
    xf = x.astype(jnp.float32)
    x1, x2 = xf[..., :half], xf[..., half:]
    return jnp.concatenate([x1 * cos - x2 * sin, x2 * cos + x1 * sin], axis=-1).astype(x.dtype)


def retention_log_decay():
    return jnp.log(1.0 - 2.0 ** (-5.0 - jnp.arange(RET_HEADS, dtype=jnp.float32)))


def retention_block(q, k, v, state, log_gamma):
    c_len = q.shape[2]
    n = jnp.arange(c_len, dtype=jnp.float32)
    lg = log_gamma[:, None]
    diff = n[:, None] - n[None, :]
    decay = jnp.where(diff >= 0, jnp.exp(lg[..., None] * jnp.maximum(diff, 0.0)), 0.0)
    qf, kf, vf = q.astype(jnp.float32), k.astype(jnp.float32), v.astype(jnp.float32)
    scores = jnp.einsum('bhnd,bhmd->bhnm', qf, kf) * decay
    inner = jnp.einsum('bhnm,bhmv->bhnv', scores, vf)
    cross = jnp.einsum('bhnd,bhdv->bhnv', qf * jnp.exp(lg * (n + 1.0))[..., None], state)
    new_state = jnp.exp(lg * c_len)[..., None] * state + jnp.einsum(
        'bhmd,bhmv->bhdv', kf * jnp.exp(lg * (c_len - 1.0 - n))[..., None], vf)
    return inner + cross, new_state


def retention_out(y, rg, gn_g):
    y = jnp.swapaxes(y, 1, 2)
    b, t = y.shape[0], y.shape[1]
    yc = y - jnp.mean(y, axis=-1, keepdims=True)
    yn = yc * lax.rsqrt(jnp.mean(yc * yc, axis=-1, keepdims=True) + EPS)
    yn = yn.reshape(b, t, RET_V_W) * gn_g.astype(jnp.float32)
    return (jax.nn.silu(rg.astype(jnp.float32)) * yn).astype(rg.dtype)


def fox_attend(q, k, v, cq, ck, allowed):
    s = jnp.einsum('bhqd,bhkd->bhqk', q.astype(jnp.float32), k.astype(jnp.float32)) * (FOX_DIM ** -0.5)
    s = s + cq[..., :, None] - ck[..., None, :]
    s = jnp.where(allowed, s, NEG_INF)
    p = jax.nn.softmax(s, axis=-1)
    return jnp.einsum('bhqk,bhkd->bhqd', p, v.astype(jnp.float32))


def project_in(h, pos, norm1_g, w_in, b_forget, q_norm_g, k_norm_g):
    b, t, _ = h.shape
    xn = rmsnorm(h, norm1_g)
    z = jnp.einsum('btd,de->bte', xn, w_in)
    cuts = [int(c) for c in np.cumsum(IN_SIZES)[:-1]]
    rq, rk, rv, rg, fq, fk, fv, ff, ga, gb = jnp.split(z, cuts, axis=-1)
    rq = rotary(rq.reshape(b, t, RET_HEADS, RET_QK_DIM), pos)
    rk = rotary(rk.reshape(b, t, RET_HEADS, RET_QK_DIM), pos) * (RET_QK_DIM ** -0.5)
    rv = rv.reshape(b, t, RET_HEADS, RET_V_DIM)
    fq = rmsnorm(fq.reshape(b, t, FOX_HEADS, FOX_DIM), q_norm_g)
    fk = rmsnorm(fk.reshape(b, t, FOX_HEADS, FOX_DIM), k_norm_g)
    fv = fv.reshape(b, t, FOX_HEADS, FOX_DIM)
    logf = jax.nn.log_sigmoid(ff.astype(jnp.float32) + b_forget.astype(jnp.float32))
    return rq, rk, rv, rg, fq, fk, fv, logf, ga, gb


def merge_and_mlp(h, ret_o, fox_o, ga, gb, w_ret_out, w_fox_out, w_o, norm2_g, w_ff1, w_ff2):
    m = jax.nn.sigmoid(ga) * (ret_o @ w_ret_out) + jax.nn.sigmoid(gb) * (fox_o @ w_fox_out)
    h = h + m @ w_o
    u = jax.nn.relu(rmsnorm(h, norm2_g) @ w_ff1)
    return h + (u * u) @ w_ff2


def prompt_layer(h, pos, valid, lw):
    (norm1_g, w_in, b_forget, q_norm_g, k_norm_g, ret_gn_g,
     w_ret_out, w_fox_out, w_o, norm2_g, w_ff1, w_ff2) = lw
    b, l_len, _ = h.shape
    rq, rk, rv, rg, fq, fk, fv, logf, ga, gb = project_in(h, pos, norm1_g, w_in, b_forget, q_norm_g, k_norm_g)
    rk = rk * valid[None, :, None, None].astype(rk.dtype)
    n_chunks = l_len // CHUNK
    log_gamma = retention_log_decay()

    def to_chunks(a):
        return a.reshape(b, n_chunks, CHUNK, a.shape[2], a.shape[3]).transpose(1, 0, 3, 2, 4)

    def step(state, qkv):
        q_c, k_c, v_c = qkv
        o_c, state = retention_block(q_c, k_c, v_c, state, log_gamma)
        return state, o_c

    s0 = jnp.zeros((b, RET_HEADS, RET_QK_DIM, RET_V_DIM), jnp.float32)
    s_fin, o = lax.scan(step, s0, (to_chunks(rq), to_chunks(rk), to_chunks(rv)))
    o = o.transpose(1, 2, 0, 3, 4).reshape(b, RET_HEADS, l_len, RET_V_DIM)
    ret_o = retention_out(o, rg, ret_gn_g)
    logf = jnp.where(valid[None, :, None], logf, 0.0)
    c = jnp.cumsum(logf, axis=1).transpose(0, 2, 1)
    qh, kh, vh = fq.transpose(0, 2, 1, 3), fk.transpose(0, 2, 1, 3), fv.transpose(0, 2, 1, 3)
    n_blocks = l_len // Q_BLOCK
    qb = qh.reshape(b, FOX_HEADS, n_blocks, Q_BLOCK, FOX_DIM).transpose(2, 0, 1, 3, 4)
    cb = c.reshape(b, FOX_HEADS, n_blocks, Q_BLOCK).transpose(2, 0, 1, 3)
    kpos = jnp.arange(l_len)

    def attend_block(args):
        q_i, c_i, blk = args
        qpos = blk * Q_BLOCK + jnp.arange(Q_BLOCK)
        allowed = (kpos[None, :] <= qpos[:, None]) & valid[None, :]
        return fox_attend(q_i, kh, vh, c_i, c, allowed)

    ob = lax.map(attend_block, (qb, cb, jnp.arange(n_blocks)))
    fox_o = ob.transpose(1, 0, 3, 2, 4).reshape(b, l_len, FOX_W).astype(h.dtype)
    h = merge_and_mlp(h, ret_o, fox_o, ga, gb, w_ret_out, w_fox_out, w_o, norm2_g, w_ff1, w_ff2)
    return h, s_fin, fk[:, META_PAD:], fv[:, META_PAD:], logf[:, META_PAD:]


def sample_layer(h, state, cache_k, cache_v, cache_logf, lw):
    (norm1_g, w_in, b_forget, q_norm_g, k_norm_g, ret_gn_g,
     w_ret_out, w_fox_out, w_o, norm2_g, w_ff1, w_ff2) = lw
    b, t, _ = h.shape
    past = cache_k.shape[1]
    pos = past + jnp.arange(t)
    rq, rk, rv, rg, fq, fk, fv, logf, ga, gb = project_in(h, pos, norm1_g, w_in, b_forget, q_norm_g, k_norm_g)
    o, s_new = retention_block(rq.transpose(0, 2, 1, 3), rk.transpose(0, 2, 1, 3), rv.transpose(0, 2, 1, 3),
                               state.astype(jnp.float32), retention_log_decay())
    ret_o = retention_out(o, rg, ret_gn_g)
    k_all = jnp.concatenate([cache_k.astype(fk.dtype), fk], axis=1).transpose(0, 2, 1, 3)
    v_all = jnp.concatenate([cache_v.astype(fv.dtype), fv], axis=1).transpose(0, 2, 1, 3)
    c = jnp.cumsum(jnp.concatenate([cache_logf.astype(jnp.float32), logf], axis=1), axis=1).transpose(0, 2, 1)
    allowed = jnp.arange(past + t)[None, :] <= (past + jnp.arange(t))[:, None]
    fo = fox_attend(fq.transpose(0, 2, 1, 3), k_all, v_all, c[..., past:], c, allowed)
    fox_o = fo.transpose(0, 2, 1, 3).reshape(b, t, FOX_W).astype(h.dtype)
    h = merge_and_mlp(h, ret_o, fox_o, ga, gb, w_ret_out, w_fox_out, w_o, norm2_g, w_ff1, w_ff2)
    return h, s_new.astype(state.dtype), fk, fv, logf


def setup_inputs(seed: int = 0) -> dict:
    key = jax.random.key(seed)
    ks = jax.random.split(key, 20)
    nrm = jax.random.normal
    x_prompt = nrm(ks[0], (BATCH, SEQ, D_MODEL), jnp.float32)
    x_sample = nrm(ks[1], (DEC_BATCH, DEC_SEQ, D_MODEL), jnp.float32)
    state_ret = 0.3 * nrm(ks[2], (DEPTH, DEC_BATCH, RET_HEADS, RET_QK_DIM, RET_V_DIM), jnp.float32)
    cache_fox_k = nrm(ks[3], (DEPTH, DEC_BATCH, PAST_LEN, FOX_HEADS, FOX_DIM), jnp.float32)
    cache_fox_v = nrm(ks[4], (DEPTH, DEC_BATCH, PAST_LEN, FOX_HEADS, FOX_DIM), jnp.float32)
    b_forget = jnp.linspace(1.0, 5.0, FOX_HEADS, dtype=jnp.float32)[None, :] + 0.1 * nrm(ks[5], (DEPTH, FOX_HEADS), jnp.float32)
    cache_fox_logf = jax.nn.log_sigmoid(
        b_forget[:, None, None, :] + 0.5 * nrm(ks[6], (DEPTH, DEC_BATCH, PAST_LEN, FOX_HEADS), jnp.float32))
    meta_tokens = nrm(ks[7], (N_META, D_MODEL), jnp.float32)
    norm1_g = 1.0 + 0.02 * nrm(ks[8], (DEPTH, D_MODEL), jnp.float32)
    w_in = nrm(ks[9], (DEPTH, D_MODEL, IN_W), jnp.float32) * D_MODEL ** -0.5
    q_norm_g = 1.0 + 0.02 * nrm(ks[10], (DEPTH, FOX_DIM), jnp.float32)
    k_norm_g = 1.0 + 0.02 * nrm(ks[11], (DEPTH, FOX_DIM), jnp.float32)
    ret_gn_g = 1.0 + 0.02 * nrm(ks[12], (DEPTH, RET_V_W), jnp.float32)
    w_ret_out = nrm(ks[13], (DEPTH, RET_V_W, D_MODEL), jnp.float32) * RET_V_W ** -0.5
    w_fox_out = nrm(ks[14], (DEPTH, FOX_W, D_MODEL), jnp.float32) * FOX_W ** -0.5
    w_o = nrm(ks[15], (DEPTH, D_MODEL, D_MODEL), jnp.float32) * D_MODEL ** -0.5
    norm2_g = 1.0 + 0.02 * nrm(ks[16], (DEPTH, D_MODEL), jnp.float32)
    w_ff1 = nrm(ks[17], (DEPTH, D_MODEL, D_FF), jnp.float32) * D_MODEL ** -0.5
    w_ff2 = nrm(ks[18], (DEPTH, D_FF, D_MODEL), jnp.float32) * D_FF ** -0.5
    return {"x_prompt": x_prompt, "x_sample": x_sample, "state_ret": state_ret,
            "cache_fox_k": cache_fox_k, "cache_fox_v": cache_fox_v, "cache_fox_logf": cache_fox_logf,
            "meta_tokens": meta_tokens, "norm1_g": norm1_g, "w_in": w_in, "b_forget": b_forget,
            "q_norm_g": q_norm_g, "k_norm_g": k_norm_g, "ret_gn_g": ret_gn_g,
            "w_ret_out": w_ret_out, "w_fox_out": w_fox_out, "w_o": w_o, "norm2_g": norm2_g,
            "w_ff1": w_ff1, "w_ff2": w_ff2}


def reference(x_prompt, x_sample, state_ret, cache_fox_k, cache_fox_v, cache_fox_logf,
              meta_tokens, norm1_g, w_in, b_forget, q_norm_g, k_norm_g, ret_gn_g,
              w_ret_out, w_fox_out, w_o, norm2_g, w_ff1, w_ff2):
    bp = x_prompt.shape[0]
    dt = x_prompt.dtype
    hp = jnp.concatenate([jnp.zeros((bp, META_PAD, D_MODEL), dt),
                          jnp.broadcast_to(meta_tokens.astype(dt)[None], (bp, N_META, D_MODEL)),
                          x_prompt], axis=1)
    pos_p = jnp.arange(hp.shape[1]) - (META_PAD + N_META)
    valid_p = pos_p >= -N_META
    hs = x_sample
    p_st, p_k, p_v, p_lf, s_st, s_k, s_v, s_lf = [], [], [], [], [], [], [], []
    for l in range(DEPTH):
        lw = (norm1_g[l], w_in[l], b_forget[l], q_norm_g[l], k_norm_g[l], ret_gn_g[l],
              w_ret_out[l], w_fox_out[l], w_o[l], norm2_g[l], w_ff1[l], w_ff2[l])
        hp, st, kr, vr, lf = prompt_layer(hp, pos_p, valid_p, lw)
        p_st.append(st)
        p_k.append(kr)
        p_v.append(vr)
        p_lf.append(lf)
        hs, st, kr, vr, lf = sample_layer(hs, state_ret[l], cache_fox_k[l], cache_fox_v[l], cache_fox_logf[l], lw)
        s_st.append(st)
        s_k.append(kr)
        s_v.append(vr)
        s_lf.append(lf)
    y_prompt = hp[:, META_PAD + N_META:]
    return (y_prompt, hs, jnp.stack(p_st), jnp.stack(p_k), jnp.stack(p_v), jnp.stack(p_lf),
            jnp.stack(s_st), jnp.stack(s_k), jnp.stack(s_v), jnp.stack(s_lf))
```

```cpp
#include <hip/hip_runtime.h>
#include <hip/hip_cooperative_groups.h>
#include <cstdio>
#include <cstdint>
namespace cg = cooperative_groups;

#ifndef MULTI_LAUNCH
#define MULTI_LAUNCH 0
#endif

typedef short bf16x8 __attribute__((ext_vector_type(8)));
typedef short s16x4 __attribute__((ext_vector_type(4)));
typedef float f32x16 __attribute__((ext_vector_type(16)));
typedef float f32x4 __attribute__((ext_vector_type(4)));
typedef float f32x2 __attribute__((ext_vector_type(2)));
typedef unsigned u32x4 __attribute__((ext_vector_type(4)));
typedef unsigned u32x2 __attribute__((ext_vector_type(2)));
typedef __bf16 bf2_t __attribute__((ext_vector_type(2)));
typedef unsigned short bf16_t;
#define DI __device__ __forceinline__
#define MFMA(a, b, c) __builtin_amdgcn_mfma_f32_32x32x16_bf16((a), (b), (c), 0, 0, 0)

constexpr int D = 1024, LP = 8320, OFF = 128, VAL0 = 112, MPR = 33280, MT = 33536, INW = 8200, DFF = 4096;
constexpr int NTM = MT / 256;
constexpr float EPS = 1e-6f, LOG2E = 1.4426950408889634f;
constexpr float ATT_SC = 0.08838834764831845f * 1.4426950408889634f;
constexpr int LDS_BYTES = 163840;

constexpr size_t SZ_ACT = (size_t)MT * 1024 * 2;
constexpr size_t WS_CTL = 0;
constexpr size_t WS_XN = 4096;
constexpr size_t WS_WIN = WS_XN + SZ_ACT;
constexpr size_t WS_WRET = WS_WIN + (size_t)8192 * 1024 * 2;
constexpr size_t WS_WFOX = WS_WRET + 2097152;
constexpr size_t WS_WO = WS_WFOX + 2097152;
constexpr size_t WS_WFF1 = WS_WO + 2097152;
constexpr size_t WS_WFF2 = WS_WFF1 + 8388608;
constexpr size_t WS_RQ = WS_WFF2 + 8388608;
constexpr size_t WS_RK = WS_RQ + SZ_ACT / 2;
constexpr size_t WS_RV = WS_RK + SZ_ACT / 2;
constexpr size_t WS_RG = WS_RV + SZ_ACT;
constexpr size_t WS_FQ = WS_RG + SZ_ACT;
constexpr size_t WS_FK = WS_FQ + SZ_ACT;
constexpr size_t WS_VT = WS_FK + SZ_ACT;
constexpr size_t WS_LOGF = WS_VT + (size_t)4 * 8 * 128 * LP * 2;
constexpr size_t WS_NCKP = WS_LOGF + (size_t)MT * 8 * 4;
constexpr size_t WS_NCKS = WS_NCKP + (size_t)32 * LP * 4;
constexpr size_t WS_ROPE = WS_NCKS + (size_t)64 * 4128 * 4;
constexpr size_t WS_SSQ = WS_ROPE + (size_t)LP * 64 * 8;
constexpr size_t WS_GAS = WS_SSQ + (size_t)MT * 8 * 4;
constexpr size_t WS_GBS = WS_GAS + 524288;
constexpr size_t WS_SSQS = WS_GBS + 524288;
constexpr size_t WS_END = WS_SSQS + 32768;
constexpr size_t WS_TG = WS_XN;
constexpr size_t WS_M = WS_RV;
constexpr size_t WS_A2 = WS_FK;
constexpr size_t WS_U = WS_RQ;
static_assert(WS_END <= (size_t)512 * 1024 * 1024, "workspace too large");
static_assert(WS_U + (size_t)MT * 4096 * 2 == WS_FK, "U alias");

constexpr size_t O_Y = 0, O_YS = 33554432, O_PST = O_YS + 262144, O_PK = O_PST + 524288, O_PV = O_PK + 33619968, O_PLF = O_PV + 33619968,
                 O_SST = O_PLF + 262656, O_SK = O_SST + 1048576, O_SV = O_SK + 262144, O_SLF = O_SV + 262144;

struct Params {
    const float* x_prompt; const float* x_sample; const float* state_ret; const float* cache_k; const float* cache_v; const float* cache_logf;
    const float* meta; const float* norm1_g; const float* w_in; const float* b_forget; const float* q_norm_g; const float* k_norm_g; const float* ret_gn_g;
    const float* w_ret_out; const float* w_fox_out; const float* w_o; const float* norm2_g; const float* w_ff1; const float* w_ff2;
    float* out; unsigned char* ws; int ph_lo, ph_hi, coop, pad;
};

DI unsigned pk2(float a, float b) { f32x2 v = {a, b}; bf2_t r = __builtin_convertvector(v, bf2_t); return __builtin_bit_cast(unsigned, r); }
DI bf16_t f2bf(float a) { return (bf16_t)(pk2(a, 0.f) & 0xffffu); }
DI float bflo(unsigned u) { return __uint_as_float(u << 16); }
DI float bfhi(unsigned u) { return __uint_as_float(u & 0xffff0000u); }
DI float bf2f(bf16_t u) { return __uint_as_float(((unsigned)u) << 16); }
DI int crow(int i, int h) { return (i & 3) + 8 * (i >> 2) + 4 * h; }
DI float ex2(float x) { return __builtin_amdgcn_exp2f(x); }
DI float frcp(float x) { return __builtin_amdgcn_rcpf(x); }
DI float frsq(float x) { return __builtin_amdgcn_rsqf(x); }
DI bf16x8 pack8(const f32x16& x, int s) {
    u32x4 p; p.x = pk2(x[8 * s], x[8 * s + 1]); p.y = pk2(x[8 * s + 2], x[8 * s + 3]); p.z = pk2(x[8 * s + 4], x[8 * s + 5]); p.w = pk2(x[8 * s + 6], x[8 * s + 7]);
    return __builtin_bit_cast(bf16x8, p);
}
DI bf16x8 cat4(s16x4 lo, s16x4 hi) { return __builtin_shufflevector(lo, hi, 0, 1, 2, 3, 4, 5, 6, 7); }
DI float wave_sum(float v) {
#pragma unroll
    for (int o = 1; o < 64; o <<= 1) v += __shfl_xor(v, o);
    return v;
}
DI float half_sum32(float v) {
#pragma unroll
    for (int o = 1; o < 32; o <<= 1) v += __shfl_xor(v, o);
    return v;
}
DI void decode_row(int r, int& samp, int& b, int& p) {
    if (r < MPR) { samp = 0; b = r / LP; p = r - b * LP; } else { samp = 1; const int s = r - MPR; b = s >> 5; p = s & 31; }
}
DI int opaque_tid() { int t = threadIdx.x; asm volatile("" : "+v"(t)); return t; }
DI f32x16 zero16() { f32x16 z; for (int i = 0; i < 16; ++i) z[i] = 0.f; return z; }

DI void p0_rows(const Params& P, unsigned char* lds) {
    float* wffT = (float*)lds;
    const int t = opaque_tid();
#pragma unroll
    for (int i = 0; i < 16; ++i) { const int idx = t + 512 * i; const int c = idx >> 3, h = idx & 7; wffT[h * 1024 + c] = P.w_in[(size_t)c * INW + 6144 + h]; }
    __syncthreads();
    const int lane = t & 63, wave = t >> 6;
    bf16_t* XN = (bf16_t*)(P.ws + WS_XN); float* LOGF = (float*)(P.ws + WS_LOGF);
    for (int r = blockIdx.x * 8 + wave; r < MT; r += gridDim.x * 8) {
        int samp, b, p; decode_row(r, samp, b, p);
        const float* src = nullptr;
        if (samp) src = P.x_sample + (size_t)(r - MPR) * D;
        else if (p >= OFF) src = P.x_prompt + ((size_t)b * 8192 + (p - OFF)) * D;
        else if (p >= VAL0) src = P.meta + (size_t)(p - VAL0) * D;
        f32x4 v[4]; float ss = 0.f;
#pragma unroll
        for (int j = 0; j < 4; ++j) {
            if (src) v[j] = *(const f32x4*)(src + 4 * lane + 256 * j); else v[j] = (f32x4){0.f, 0.f, 0.f, 0.f};
            ss += v[j].x * v[j].x + v[j].y * v[j].y + v[j].z * v[j].z + v[j].w * v[j].w;
        }
        ss = wave_sum(ss);
        const float rstd = frsq(ss * (1.f / 1024.f) + EPS);
        float dot[8];
#pragma unroll
        for (int h = 0; h < 8; ++h) dot[h] = 0.f;
#pragma unroll
        for (int j = 0; j < 4; ++j) {
            const f32x4 g = *(const f32x4*)(P.norm1_g + 4 * lane + 256 * j);
            v[j] = v[j] * rstd * g;
            u32x2 o; o.x = pk2(v[j].x, v[j].y); o.y = pk2(v[j].z, v[j].w);
            *(u32x2*)(XN + (size_t)r * D + 4 * lane + 256 * j) = o;
#pragma unroll
            for (int h = 0; h < 8; ++h) { const f32x4 w = *(const f32x4*)(wffT + h * 1024 + 4 * lane + 256 * j); dot[h] += v[j].x * w.x + v[j].y * w.y + v[j].z * w.z + v[j].w * w.w; }
        }
#pragma unroll
        for (int h = 0; h < 8; ++h) dot[h] = wave_sum(dot[h]);
        float mine = dot[0];
#pragma unroll
        for (int h = 1; h < 8; ++h) mine = (lane == h) ? dot[h] : mine;
        if (lane < 8) {
            const float vv = mine + P.b_forget[lane];
            float lf = fminf(vv, 0.f) - log1pf(__expf(-fabsf(vv)));
            if (!samp && p < VAL0) lf = 0.f;
            LOGF[(size_t)r * 8 + lane] = lf;
            if (samp) P.out[O_SLF + (size_t)(r - MPR) * 8 + lane] = lf;
            else if (p >= VAL0) P.out[O_PLF + ((size_t)b * 8208 + (p - VAL0)) * 8 + lane] = lf;
        }
    }
    __syncthreads();
}

DI void transpose_item(const float* W, int ldw, int col0, int K, bf16_t* WT, int n0, int k0, float* tile) {
    const int t = opaque_tid(); const int nn = t & 63, kb = t >> 6;
#pragma unroll
    for (int i = 0; i < 8; ++i) { const int kk = kb + 8 * i; tile[kk * 65 + nn] = W[(size_t)(k0 + kk) * ldw + col0 + nn]; }
    __syncthreads();
    const int n = t >> 3, kc = t & 7;
    float f[8];
#pragma unroll
    for (int e = 0; e < 8; ++e) f[e] = tile[(8 * kc + e) * 65 + n];
    u32x4 o; o.x = pk2(f[0], f[1]); o.y = pk2(f[2], f[3]); o.z = pk2(f[4], f[5]); o.w = pk2(f[6], f[7]);
    *(u32x4*)(WT + (size_t)(n0 + n) * K + k0 + 8 * kc) = o;
    __syncthreads();
}

DI void p0_weights(const Params& P, unsigned char* lds, int part) {
    float* tile = (float*)lds;
    constexpr int I0 = 16 * 128, I1 = 256, I4 = 16 * 64, I5 = 64 * 16;
    constexpr int NIT = I0 + 3 * I1 + I4 + I5;
    constexpr int SHORT0 = (NTM * 32) % 256;
    const bool split = gridDim.x == 256;
    const int lo = part == 0 ? 0 : I0, hi = part == 0 ? (split ? I0 : NIT) : (split ? NIT : 0);
    const int rank = (part == 1) ? (int)blockIdx.x - SHORT0 : (int)blockIdx.x, nranks = (part == 1) ? (int)gridDim.x - SHORT0 : (int)gridDim.x;
    if (rank < 0) return;
    for (int it = lo + rank; it < hi; it += nranks) {
        int r = it;
        if (r < I0) { const int kt = r / 128, nt = r % 128; const int n0 = nt * 64; transpose_item(P.w_in, INW, n0 + (n0 >= 6144 ? 8 : 0), 1024, (bf16_t*)(P.ws + WS_WIN), n0, kt * 64, tile); continue; } r -= I0;
        if (r < I1) { transpose_item(P.w_ret_out, 1024, (r % 16) * 64, 1024, (bf16_t*)(P.ws + WS_WRET), (r % 16) * 64, (r / 16) * 64, tile); continue; } r -= I1;
        if (r < I1) { transpose_item(P.w_fox_out, 1024, (r % 16) * 64, 1024, (bf16_t*)(P.ws + WS_WFOX), (r % 16) * 64, (r / 16) * 64, tile); continue; } r -= I1;
        if (r < I1) { transpose_item(P.w_o, 1024, (r % 16) * 64, 1024, (bf16_t*)(P.ws + WS_WO), (r % 16) * 64, (r / 16) * 64, tile); continue; } r -= I1;
        if (r < I4) { transpose_item(P.w_ff1, 4096, (r % 64) * 64, 1024, (bf16_t*)(P.ws + WS_WFF1), (r % 64) * 64, (r / 64) * 64, tile); continue; } r -= I4;
        transpose_item(P.w_ff2, 1024, (r % 16) * 64, 4096, (bf16_t*)(P.ws + WS_WFF2), (r % 16) * 64, (r / 16) * 64, tile);
    }
}

DI void p0_misc(const Params& P) {
    f32x2* ROPE = (f32x2*)(P.ws + WS_ROPE);
    for (int idx = blockIdx.x * 512 + threadIdx.x; idx < LP * 64; idx += gridDim.x * 512) {
        const int pp = idx >> 6, c = idx & 63;
        const float pos = (float)(pp - 128);
        const float inv = exp2f(-(float)c * (13.287712379549449f / 64.f));
        const float ang = pos * inv;
        double td = (double)ang * 0.15915494309189535; td -= __builtin_rint(td);
        const float tf = (float)td;
        f32x2 cs; cs.x = __builtin_amdgcn_cosf(tf); cs.y = __builtin_amdgcn_sinf(tf);
        ROPE[idx] = cs;
    }
    if (blockIdx.x == 0) { ((unsigned*)(P.ws + WS_CTL))[threadIdx.x] = 0u; ((unsigned*)(P.ws + WS_CTL))[threadIdx.x + 512] = 0u; }
}

#define AS_GLOBAL __attribute__((address_space(1)))
#define AS_LDS __attribute__((address_space(3)))
DI void dma16(const void* g, unsigned char* l) { __builtin_amdgcn_global_load_lds((const AS_GLOBAL unsigned*)g, (AS_LDS unsigned*)l, 16, 0, 0); }
template <int NBW>
DI void gemm_mainloop(f32x16 (&acc)[2][NBW], const bf16_t* A, size_t lda, int m0, const bf16_t* Bt, size_t ldb, int n0, int K, unsigned char* lds, bool pre = false, bool only_issue = false) {
    constexpr int STAGE = 65536, BOFF = 32768;
    const int t = opaque_tid(), w = t >> 6, lane = t & 63, r = lane & 31, hh = lane >> 5, wm = w >> 1, wn = w & 1;
    const int drow = w * 8 + (lane >> 3);
    const int lchunk = (lane & 7) ^ ((drow >> 1) & 7);
    const bf16_t* ap = A + (size_t)(m0 + drow) * lda + lchunk * 8;
    const bf16_t* bp = Bt + (size_t)n0 * ldb + lchunk * 8;
    size_t bro[NBW];
#pragma unroll
    for (int j = 0; j < NBW; ++j) {
        const int rho = 64 * j + drow; const int wnh = rho / (32 * NBW), wi = rho % (32 * NBW);
        bro[j] = (size_t)(wnh * 32 * NBW + NBW * (wi & 31) + (wi >> 5)) * ldb;
    }
    unsigned char* ldst = lds + w * 1024 + lane * 16;
#define GEMM_ISSUE(KT, ST) do { const int k1_ = (KT) << 6; unsigned char* d_ = ldst + (ST) * STAGE; \
        _Pragma("unroll") for (int j_ = 0; j_ < 4; ++j_) dma16(ap + (size_t)(64 * j_) * lda + k1_, d_ + j_ * 8192); \
        _Pragma("unroll") for (int j_ = 0; j_ < NBW; ++j_) dma16(bp + bro[j_] + k1_, d_ + BOFF + j_ * 8192); } while (0)
    if (!pre) GEMM_ISSUE(0, 0);
    if (only_issue) return;
    __syncthreads();
    const int nk = K >> 6;
    const int xr = (r >> 1) & 7;
    int xo[4];
#pragma unroll
    for (int s = 0; s < 4; ++s) xo[s] = ((2 * s + hh) ^ xr) << 4;
    const int aofs = (wm * 64 + r) * 128;
    const int bofs = BOFF + (wn * 32 * NBW + r) * 128;
#pragma unroll 1
    for (int kt = 0; kt < nk; ++kt) {
        const unsigned char* st = lds + (kt & 1) * STAGE;
#pragma unroll
        for (int s = 0; s < 4; ++s) {
            if (s == 1 && kt + 1 < nk) GEMM_ISSUE(kt + 1, (kt + 1) & 1);
            bf16x8 a[2], b[NBW];
#pragma unroll
            for (int mb = 0; mb < 2; ++mb) a[mb] = *(const bf16x8*)(st + aofs + mb * 4096 + xo[s]);
#pragma unroll
            for (int nb = 0; nb < NBW; ++nb) b[nb] = *(const bf16x8*)(st + bofs + nb * 4096 + xo[s]);
#pragma unroll
            for (int mb = 0; mb < 2; ++mb)
#pragma unroll
                for (int nb = 0; nb < NBW; ++nb) acc[mb][nb] = MFMA(a[mb], b[nb], acc[mb][nb]);
        }
        __syncthreads();
    }
#undef GEMM_ISSUE
}

DI void epi_p1(const Params& P, f32x16 (&acc)[2][4], int m0, int n0) {
    const int t = opaque_tid(), w = t >> 6, lane = t & 63, r = lane & 31, hh = lane >> 5, wm = w >> 1, wn = w & 1;
    const int seg = (n0 + wn * 128) >> 7;
    unsigned char* ws = P.ws; float* out = P.out;
    const int rbase = m0 + wm * 64 + 4 * hh;
    const int c4 = 4 * r;
    if (seg < 8) {
        const bool isk = seg >= 4; const int head = seg & 3;
        bf16_t* dst = (bf16_t*)(ws + (isk ? WS_RK : WS_RQ)); const float scl = isk ? 0.08838834764831845f : 1.f;
        const float* rope = (const float*)(ws + WS_ROPE);
        const float sgn = (r < 16) ? -1.f : 1.f; const int f4 = 4 * (r & 15);
#pragma unroll
        for (int mb = 0; mb < 2; ++mb)
#pragma unroll
            for (int g = 0; g < 4; ++g) {
                const int rowb = rbase + mb * 32 + 8 * g; int samp, b, p0; decode_row(rowb, samp, b, p0);
                const int ridx0 = samp ? 4224 + p0 : p0;
#pragma unroll
                for (int e = 0; e < 4; ++e) {
                    const int i = 4 * g + e; const size_t row = rowb + e;
                    const f32x4 cs0 = *(const f32x4*)(rope + ((size_t)(ridx0 + e) * 64 + f4) * 2), cs1 = *(const f32x4*)(rope + ((size_t)(ridx0 + e) * 64 + f4) * 2 + 4);
                    const float cc[4] = {cs0.x, cs0.z, cs1.x, cs1.z}, sn[4] = {cs0.y, cs0.w, cs1.y, cs1.w};
                    float o[4];
#pragma unroll
                    for (int nb = 0; nb < 4; ++nb) { const float v = acc[mb][nb][i]; const float pv = __shfl_xor(v, 16); o[nb] = (v * cc[nb] + sgn * pv * sn[nb]) * scl; }
                    u32x2 ov; ov.x = pk2(o[0], o[1]); ov.y = pk2(o[2], o[3]);
                    __builtin_nontemporal_store(ov, (u32x2*)(dst + row * 512 + head * 128 + c4));
                }
            }
    } else if (seg < 24) {
        bf16_t* dst = (bf16_t*)(ws + (seg < 16 ? WS_RV : WS_RG)); const int cb = (seg & 7) * 128 + c4;
#pragma unroll
        for (int mb = 0; mb < 2; ++mb)
#pragma unroll
            for (int i = 0; i < 16; ++i) {
                const size_t row = rbase + mb * 32 + (i & 3) + 8 * (i >> 2);
                u32x2 ov; ov.x = pk2(acc[mb][0][i], acc[mb][1][i]); ov.y = pk2(acc[mb][2][i], acc[mb][3][i]);
                __builtin_nontemporal_store(ov, (u32x2*)(dst + row * 1024 + cb));
            }
    } else if (seg < 40) {
        const bool isk = seg >= 32; const int head = seg & 7;
        const f32x4 gv = *(const f32x4*)((isk ? P.k_norm_g : P.q_norm_g) + c4);
        bf16_t* dst = (bf16_t*)(ws + (isk ? WS_FK : WS_FQ));
#pragma unroll
        for (int mb = 0; mb < 2; ++mb)
#pragma unroll
            for (int g = 0; g < 4; ++g) {
                const int rowb = rbase + mb * 32 + 8 * g; int samp, b, p0; decode_row(rowb, samp, b, p0);
#pragma unroll
                for (int e = 0; e < 4; ++e) {
                    const int i = 4 * g + e; const size_t row = rowb + e; const int p = p0 + e;
                    float ss = 0.f;
#pragma unroll
                    for (int nb = 0; nb < 4; ++nb) ss += acc[mb][nb][i] * acc[mb][nb][i];
                    ss = half_sum32(ss);
                    const float rstd = frsq(ss * (1.f / 128.f) + EPS);
                    f32x4 y; y.x = acc[mb][0][i] * rstd * gv.x; y.y = acc[mb][1][i] * rstd * gv.y; y.z = acc[mb][2][i] * rstd * gv.z; y.w = acc[mb][3][i] * rstd * gv.w;
                    u32x2 ov; ov.x = pk2(y.x, y.y); ov.y = pk2(y.z, y.w);
                    __builtin_nontemporal_store(ov, (u32x2*)(dst + row * 1024 + head * 128 + c4));
                    if (isk) {
                        if (samp) __builtin_nontemporal_store(y, (f32x4*)(out + O_SK + ((size_t)(b * 32 + p) * 8 + head) * 128 + c4));
                        else if (p >= VAL0) __builtin_nontemporal_store(y, (f32x4*)(out + O_PK + (((size_t)b * 8208 + (p - VAL0)) * 8 + head) * 128 + c4));
                    }
                }
            }
    } else if (seg < 48) {
        const int head = seg & 7; bf16_t* VT = (bf16_t*)(ws + WS_VT);
#pragma unroll
        for (int mb = 0; mb < 2; ++mb)
#pragma unroll
            for (int g = 0; g < 4; ++g) {
                const int rowb = rbase + mb * 32 + 8 * g; int samp, b, p0; decode_row(rowb, samp, b, p0);
#pragma unroll
                for (int e = 0; e < 4; ++e) {
                    const int i = 4 * g + e; const int p = p0 + e;
                    f32x4 y; y.x = acc[mb][0][i]; y.y = acc[mb][1][i]; y.z = acc[mb][2][i]; y.w = acc[mb][3][i];
                    if (samp) __builtin_nontemporal_store(y, (f32x4*)(out + O_SV + ((size_t)(b * 32 + p) * 8 + head) * 128 + c4));
                    else if (p >= VAL0) __builtin_nontemporal_store(y, (f32x4*)(out + O_PV + (((size_t)b * 8208 + (p - VAL0)) * 8 + head) * 128 + c4));
                }
                if (!samp) {
#pragma unroll
                    for (int nb = 0; nb < 4; ++nb) {
                        u32x2 o; o.x = pk2(acc[mb][nb][4 * g], acc[mb][nb][4 * g + 1]); o.y = pk2(acc[mb][nb][4 * g + 2], acc[mb][nb][4 * g + 3]);
                        *(u32x2*)(VT + ((size_t)((b * 8 + head) * 128 + c4 + nb)) * LP + p0) = o;
                    }
                }
            }
    } else {
        const bool isb = seg >= 56; const int cb = (seg & 7) * 128 + c4;
        bf16_t* dp = (bf16_t*)out + (isb ? (size_t)33554432 : 0);
        bf16_t* dsm = (bf16_t*)(ws + (isb ? WS_GBS : WS_GAS));
#pragma unroll
        for (int mb = 0; mb < 2; ++mb)
#pragma unroll
            for (int g = 0; g < 4; ++g) {
                const int rowb = rbase + mb * 32 + 8 * g; int samp, b, p0; decode_row(rowb, samp, b, p0);
#pragma unroll
                for (int e = 0; e < 4; ++e) {
                    const int i = 4 * g + e; const int p = p0 + e;
                    bf16_t* d = nullptr;
                    if (samp) d = dsm + (size_t)(b * 32 + p) * 1024; else if (p >= OFF) d = dp + ((size_t)b * 8192 + (p - OFF)) * 1024;
                    if (d) {
                        float s[4];
#pragma unroll
                        for (int nb = 0; nb < 4; ++nb) s[nb] = frcp(1.f + ex2(-LOG2E * acc[mb][nb][i]));
                        u32x2 ov; ov.x = pk2(s[0], s[1]); ov.y = pk2(s[2], s[3]);
                        __builtin_nontemporal_store(ov, (u32x2*)(d + cb));
                    }
                }
            }
    }
}

DI void phase_p1(const Params& P, unsigned char* lds) {
    const bf16_t* A = (const bf16_t*)(P.ws + WS_XN); const bf16_t* Bt = (const bf16_t*)(P.ws + WS_WIN);
    constexpr int NTN = 32;
    bool pre = false;
#pragma unroll 1
    for (int tile = blockIdx.x; tile < NTM * NTN; tile += gridDim.x) {
        const int mt = tile / NTN, nt = tile % NTN;
        f32x16 acc[2][4];
#pragma unroll
        for (int a = 0; a < 2; ++a)
#pragma unroll
            for (int b = 0; b < 4; ++b) acc[a][b] = zero16();
        gemm_mainloop<4>(acc, A, 1024, mt * 256, Bt, 1024, nt * 256, 1024, lds, pre);
        { const int tn = tile + gridDim.x; pre = tn < NTM * NTN; if (pre) { const int mtn = tn / NTN, ntn_ = tn % NTN; f32x16 (&dummy)[2][4] = acc; gemm_mainloop<4>(dummy, A, 1024, mtn * 256, Bt, 1024, ntn_ * 256, 1024, lds, false, true); } }
        epi_p1(P, acc, mt * 256, nt * 256);
    }
}

DI void small_tile(const bf16_t* A, size_t lda, int a0, const bf16_t* Bt, size_t ldb, int b0, int K, float* ctile, float* red) {
    const int t = opaque_tid(), w = t >> 6, lane = t & 63, r = lane & 31, hh = lane >> 5;
    const int kper = K >> 3;
    const bf16_t* ap = A + (size_t)(a0 + r) * lda + w * kper + 8 * hh;
    const bf16_t* bp = Bt + (size_t)(b0 + r) * ldb + w * kper + 8 * hh;
    f32x16 acc = zero16();
#pragma unroll 4
    for (int k = 0; k < kper; k += 16) acc = MFMA(*(const bf16x8*)(ap + k), *(const bf16x8*)(bp + k), acc);
#pragma unroll
    for (int i = 0; i < 16; ++i) red[w * 1024 + i * 64 + lane] = acc[i];
    __syncthreads();
#pragma unroll
    for (int q = 0; q < 2; ++q) {
        const int e = t + 512 * q; float s = 0.f;
#pragma unroll
        for (int ww = 0; ww < 8; ++ww) s += red[ww * 1024 + e];
        const int i = e >> 6, ln = e & 63;
        ctile[crow(i, ln >> 5) * 33 + (ln & 31)] = s;
    }
    __syncthreads();
}

DI void phase_p4(const Params& P, unsigned char* lds) {
    const bf16_t* RO = (const bf16_t*)(P.ws + WS_RG); const bf16_t* FO = (const bf16_t*)(P.ws + WS_FQ);
    const bf16_t* W1 = (const bf16_t*)(P.ws + WS_WRET); const bf16_t* W2 = (const bf16_t*)(P.ws + WS_WFOX);
    bf16_t* M = (bf16_t*)(P.ws + WS_M);
    const bf16_t* GAp = (const bf16_t*)P.out; const bf16_t* GBp = GAp + (size_t)33554432;
    const bf16_t* GAs = (const bf16_t*)(P.ws + WS_GAS); const bf16_t* GBs = (const bf16_t*)(P.ws + WS_GBS);
    const int t = opaque_tid(), w = t >> 6, lane = t & 63, r = lane & 31, hh = lane >> 5, wm = w >> 1, wn = w & 1;
    constexpr int NTN = 8;
    bool pre = false;
#pragma unroll 1
    for (int tile = blockIdx.x; tile < 128 * NTN; tile += gridDim.x) {
        const int mt = tile / NTN, nt = tile % NTN; const int m0 = (mt >> 5) * LP + OFF + (mt & 31) * 256, n0 = nt * 128;
        f32x16 a1[2][2], a2[2][2];
#pragma unroll
        for (int a = 0; a < 2; ++a)
#pragma unroll
            for (int b = 0; b < 2; ++b) { a1[a][b] = zero16(); a2[a][b] = zero16(); }
        gemm_mainloop<2>(a1, RO, 1024, m0, W1, 1024, n0, 1024, lds, pre);
        gemm_mainloop<2>(a2, FO, 1024, m0, W2, 1024, n0, 1024, lds);
        { const int tn = tile + gridDim.x; pre = tn < 128 * NTN; if (pre) { const int mtn = tn / NTN, ntn_ = tn % NTN; gemm_mainloop<2>(a1, RO, 1024, (mtn >> 5) * LP + OFF + (mtn & 31) * 256, W1, 1024, ntn_ * 128, 1024, lds, false, true); } }
        const int col = n0 + wn * 64 + 2 * r;
        const size_t crow0 = (size_t)mt * 256 + wm * 64 + 4 * hh;
#pragma unroll
        for (int mb = 0; mb < 2; ++mb) {
            unsigned ua[16], ub[16];
#pragma unroll
            for (int i = 0; i < 16; ++i) {
                const size_t ci = (crow0 + mb * 32 + (i & 3) + 8 * (i >> 2)) * 1024 + col;
                ua[i] = *(const unsigned*)(GAp + ci); ub[i] = *(const unsigned*)(GBp + ci);
            }
#pragma unroll
            for (int i = 0; i < 16; ++i) {
                const size_t row = (size_t)m0 + wm * 64 + mb * 32 + crow(i, hh);
                const float m0v = bflo(ua[i]) * a1[mb][0][i] + bflo(ub[i]) * a2[mb][0][i];
                const float m1v = bfhi(ua[i]) * a1[mb][1][i] + bfhi(ub[i]) * a2[mb][1][i];
                __builtin_nontemporal_store(pk2(m0v, m1v), (unsigned*)(M + row * 1024 + col));
            }
        }
    }
    {
        float* red = (float*)lds; float* c1 = (float*)(lds + 32768); float* c2 = (float*)(lds + 32768 + 4352);
#pragma unroll 1
        for (int pc = blockIdx.x; pc < 8 * 32; pc += gridDim.x) {
            const int rg = pc >> 5, cg = pc & 31;
            small_tile(RO, 1024, MPR + 32 * rg, W1, 1024, 32 * cg, 1024, c1, red);
            small_tile(FO, 1024, MPR + 32 * rg, W2, 1024, 32 * cg, 1024, c2, red);
            const int rl = t >> 4, cl = (t & 15) * 2; const int srow = 32 * rg + rl, col = 32 * cg + cl;
            const unsigned ua = *(const unsigned*)(GAs + (size_t)srow * 1024 + col), ub = *(const unsigned*)(GBs + (size_t)srow * 1024 + col);
            const float m0v = bflo(ua) * c1[rl * 33 + cl] + bflo(ub) * c2[rl * 33 + cl];
            const float m1v = bfhi(ua) * c1[rl * 33 + cl + 1] + bfhi(ub) * c2[rl * 33 + cl + 1];
            __builtin_nontemporal_store(pk2(m0v, m1v), (unsigned*)(M + (size_t)(MPR + srow) * 1024 + col));
            __syncthreads();
        }
    }
}

DI void phase_p5(const Params& P, unsigned char* lds) {
    const bf16_t* M = (const bf16_t*)(P.ws + WS_M); const bf16_t* W = (const bf16_t*)(P.ws + WS_WO);
    bf16_t* A2 = (bf16_t*)(P.ws + WS_A2); float* SSQ = (float*)(P.ws + WS_SSQ);
    const int t = opaque_tid(), w = t >> 6, lane = t & 63, r = lane & 31, hh = lane >> 5, wm = w >> 1, wn = w & 1;
    constexpr int NTN = 4;
    bool pre = false;
#pragma unroll 1
    for (int tile = blockIdx.x; tile < 128 * NTN; tile += gridDim.x) {
        const int mt = tile / NTN, nt = tile % NTN; const int m0 = (mt >> 5) * LP + OFF + (mt & 31) * 256, n0 = nt * 256;
        f32x16 acc[2][4];
#pragma unroll
        for (int a = 0; a < 2; ++a)
#pragma unroll
            for (int b = 0; b < 4; ++b) acc[a][b] = zero16();
        gemm_mainloop<4>(acc, M, 1024, m0, W, 1024, n0, 1024, lds, pre);
        { const int tn = tile + gridDim.x; pre = tn < 128 * NTN; if (pre) { const int mtn = tn / NTN, ntn_ = tn % NTN; f32x16 (&dummy)[2][4] = acc; gemm_mainloop<4>(dummy, M, 1024, (mtn >> 5) * LP + OFF + (mtn & 31) * 256, W, 1024, ntn_ * 256, 1024, lds, false, true); } }
        const int col = n0 + wn * 128 + 4 * r;
        const f32x4 g2 = *(const f32x4*)(P.norm2_g + col);
        const size_t crow0 = (size_t)mt * 256 + wm * 64 + 4 * hh;
#pragma unroll
        for (int mb = 0; mb < 2; ++mb) {
#pragma unroll
          for (int hf = 0; hf < 2; ++hf) {
            f32x4 xv[16];
#pragma unroll
            for (int i = 8 * hf; i < 8 * hf + 8; ++i) xv[i] = *(const f32x4*)(P.x_prompt + (crow0 + mb * 32 + (i & 3) + 8 * (i >> 2)) * 1024 + col);
#pragma unroll
            for (int i = 8 * hf; i < 8 * hf + 8; ++i) {
                const size_t lr = mb * 32 + (i & 3) + 8 * (i >> 2); const size_t row = (size_t)m0 + wm * 64 + 4 * hh + lr;
                f32x4 h2; h2.x = xv[i].x + acc[mb][0][i]; h2.y = xv[i].y + acc[mb][1][i]; h2.z = xv[i].z + acc[mb][2][i]; h2.w = xv[i].w + acc[mb][3][i];
                __builtin_nontemporal_store(h2, (f32x4*)(P.out + O_Y + (crow0 + lr) * 1024 + col));
                u32x2 ov; ov.x = pk2(h2.x * g2.x, h2.y * g2.y); ov.y = pk2(h2.z * g2.z, h2.w * g2.w);
                __builtin_nontemporal_store(ov, (u32x2*)(A2 + row * 1024 + col));
                float ss = (h2.x * h2.x + h2.y * h2.y) + (h2.z * h2.z + h2.w * h2.w);
                ss = half_sum32(ss);
                if (r == 0) SSQ[row * 8 + nt * 2 + wn] = ss;
            }
          }
        }
    }
    {
        float* red = (float*)lds; float* c1 = (float*)(lds + 32768); float* SSQS = (float*)(P.ws + WS_SSQS);
#pragma unroll 1
        for (int pc = blockIdx.x; pc < 8 * 32; pc += gridDim.x) {
            const int rg = pc >> 5, cg = pc & 31;
            small_tile(M, 1024, MPR + 32 * rg, W, 1024, 32 * cg, 1024, c1, red);
            const int rl = t >> 4, cl = (t & 15) * 2; const int srow = 32 * rg + rl, col = 32 * cg + cl;
            const f32x2 xv = *(const f32x2*)(P.x_sample + (size_t)srow * 1024 + col);
            f32x2 h2; h2.x = xv.x + c1[rl * 33 + cl]; h2.y = xv.y + c1[rl * 33 + cl + 1];
            __builtin_nontemporal_store(h2, (f32x2*)(P.out + O_YS + (size_t)srow * 1024 + col));
            const f32x2 g2 = *(const f32x2*)(P.norm2_g + col);
            __builtin_nontemporal_store(pk2(h2.x * g2.x, h2.y * g2.y), (unsigned*)(A2 + (size_t)(MPR + srow) * 1024 + col));
            float ss = h2.x * h2.x + h2.y * h2.y;
#pragma unroll
            for (int o = 1; o < 16; o <<= 1) ss += __shfl_xor(ss, o);
            if ((t & 15) == 0) SSQS[srow * 32 + cg] = ss;
            __syncthreads();
        }
    }
}

DI void phase_p6(const Params& P, unsigned char* lds) {
    const bf16_t* A2 = (const bf16_t*)(P.ws + WS_A2); const bf16_t* W = (const bf16_t*)(P.ws + WS_WFF1);
    bf16_t* U = (bf16_t*)(P.ws + WS_U); const float* SSQ = (const float*)(P.ws + WS_SSQ);
    const int t = opaque_tid(), w = t >> 6, lane = t & 63, r = lane & 31, hh = lane >> 5, wm = w >> 1, wn = w & 1;
    constexpr int NTN = 16;
    bool pre = false; int rtpar = 0;
#pragma unroll 1
    for (int tile = blockIdx.x; tile < 128 * NTN; tile += gridDim.x) {
        const int mt = tile / NTN, nt = tile % NTN; const int m0 = (mt >> 5) * LP + OFF + (mt & 31) * 256, n0 = nt * 256;
        f32x16 acc[2][4];
#pragma unroll
        for (int a = 0; a < 2; ++a)
#pragma unroll
            for (int b = 0; b < 4; ++b) acc[a][b] = zero16();
        {
            float* rt = (float*)(lds + 131072 + (rtpar & 1) * 1024);
            if (t < 256) {
                const size_t row = (size_t)m0 + t;
                const f32x4 s0 = *(const f32x4*)(SSQ + row * 8), s1 = *(const f32x4*)(SSQ + row * 8 + 4);
                const float ss = ((s0.x + s0.y) + (s0.z + s0.w)) + ((s1.x + s1.y) + (s1.z + s1.w));
                rt[t] = frsq(ss * (1.f / 1024.f) + EPS);
            }
        }
        gemm_mainloop<4>(acc, A2, 1024, m0, W, 1024, n0, 1024, lds, pre);
        { const int tn = tile + gridDim.x; pre = tn < 128 * NTN; if (pre) { const int mtn = tn / NTN, ntn_ = tn % NTN; f32x16 (&dummy)[2][4] = acc; gemm_mainloop<4>(dummy, A2, 1024, (mtn >> 5) * LP + OFF + (mtn & 31) * 256, W, 1024, ntn_ * 256, 1024, lds, false, true); } }
        const int col = n0 + wn * 128 + 4 * r;
#pragma unroll
        for (int mb = 0; mb < 2; ++mb)
#pragma unroll
            for (int i = 0; i < 16; ++i) {
                const size_t row = m0 + wm * 64 + mb * 32 + crow(i, hh);
                const float rstd = ((const float*)(lds + 131072 + (rtpar & 1) * 1024))[wm * 64 + mb * 32 + crow(i, hh)];
                float u[4];
#pragma unroll
                for (int nb = 0; nb < 4; ++nb) { const float v = fmaxf(acc[mb][nb][i] * rstd, 0.f); u[nb] = v * v; }
                u32x2 ov; ov.x = pk2(u[0], u[1]); ov.y = pk2(u[2], u[3]);
                __builtin_nontemporal_store(ov, (u32x2*)(U + row * 4096 + col));
            }
        ++rtpar;
    }
    {
        float* red = (float*)lds; float* c1 = (float*)(lds + 32768); const float* SSQS = (const float*)(P.ws + WS_SSQS);
#pragma unroll 1
        for (int pc = blockIdx.x; pc < 8 * 128; pc += gridDim.x) {
            const int rg = pc >> 7, cg = pc & 127;
            small_tile(A2, 1024, MPR + 32 * rg, W, 1024, 32 * cg, 1024, c1, red);
            const int rl = t >> 4, cl = (t & 15) * 2; const int srow = 32 * rg + rl, col = 32 * cg + cl;
            float ss = 0.f;
#pragma unroll
            for (int j = 0; j < 8; ++j) { const f32x4 sv = *(const f32x4*)(SSQS + srow * 32 + 4 * j); ss += (sv.x + sv.y) + (sv.z + sv.w); }
            const float rstd = frsq(ss * (1.f / 1024.f) + EPS);
            const float u0 = fmaxf(c1[rl * 33 + cl] * rstd, 0.f), u1 = fmaxf(c1[rl * 33 + cl + 1] * rstd, 0.f);
            __builtin_nontemporal_store(pk2(u0 * u0, u1 * u1), (unsigned*)(U + (size_t)(MPR + srow) * 4096 + col));
            __syncthreads();
        }
    }
}

DI void phase_p7(const Params& P, unsigned char* lds) {
    const bf16_t* U = (const bf16_t*)(P.ws + WS_U); const bf16_t* W = (const bf16_t*)(P.ws + WS_WFF2);
    const int t = opaque_tid(), w = t >> 6, lane = t & 63, r = lane & 31, hh = lane >> 5, wm = w >> 1, wn = w & 1;
    constexpr int NTN = 4;
    bool pre = false;
#pragma unroll 1
    for (int tile = blockIdx.x; tile < 128 * NTN; tile += gridDim.x) {
        const int mt = tile / NTN, nt = tile % NTN; const int m0 = (mt >> 5) * LP + OFF + (mt & 31) * 256, n0 = nt * 256;
        f32x16 acc[2][4];
#pragma unroll
        for (int a = 0; a < 2; ++a)
#pragma unroll
            for (int b = 0; b < 4; ++b) acc[a][b] = zero16();
        gemm_mainloop<4>(acc, U, 4096, m0, W, 4096, n0, 4096, lds, pre);
        { const int tn = tile + gridDim.x; pre = tn < 128 * NTN; if (pre) { const int mtn = tn / NTN, ntn_ = tn % NTN; f32x16 (&dummy)[2][4] = acc; gemm_mainloop<4>(dummy, U, 4096, (mtn >> 5) * LP + OFF + (mtn & 31) * 256, W, 4096, ntn_ * 256, 4096, lds, false, true); } }
        const int col = n0 + wn * 128 + 4 * r;
        const size_t crow0 = (size_t)mt * 256 + wm * 64 + 4 * hh;
#pragma unroll
        for (int mb = 0; mb < 2; ++mb) {
#pragma unroll
          for (int hf = 0; hf < 2; ++hf) {
            f32x4 yv[16];
#pragma unroll
            for (int i = 8 * hf; i < 8 * hf + 8; ++i) yv[i] = *(const f32x4*)(P.out + O_Y + (crow0 + mb * 32 + (i & 3) + 8 * (i >> 2)) * 1024 + col);
#pragma unroll
            for (int i = 8 * hf; i < 8 * hf + 8; ++i) {
                f32x4 o = yv[i]; o.x += acc[mb][0][i]; o.y += acc[mb][1][i]; o.z += acc[mb][2][i]; o.w += acc[mb][3][i];
                __builtin_nontemporal_store(o, (f32x4*)(P.out + O_Y + (crow0 + mb * 32 + (i & 3) + 8 * (i >> 2)) * 1024 + col));
            }
          }
        }
    }
    {
        float* red = (float*)lds; float* c1 = (float*)(lds + 32768);
#pragma unroll 1
        for (int pc = blockIdx.x; pc < 8 * 32; pc += gridDim.x) {
            const int rg = pc >> 5, cg = pc & 31;
            small_tile(U, 4096, MPR + 32 * rg, W, 4096, 32 * cg, 4096, c1, red);
            const int rl = t >> 4, cl = (t & 15) * 2; const int srow = 32 * rg + rl, col = 32 * cg + cl;
            f32x2* yp = (f32x2*)(P.out + O_YS + (size_t)srow * 1024 + col);
            f32x2 yv = *yp; yv.x += c1[rl * 33 + cl]; yv.y += c1[rl * 33 + cl + 1]; *yp = yv;
            __syncthreads();
        }
    }
}

template <bool OUT>
DI void ret_chunk(const Params& P, unsigned char* lds, f32x16 (&S)[4], size_t row0, int CL, int head, float lg2_in) {
    float lg2 = lg2_in; asm volatile("" : "+v"(lg2));
    const int t = opaque_tid(), w = t >> 6, lane = t & 63, r = lane & 31, hh = lane >> 5;
    const bf16_t* RQ = (const bf16_t*)(P.ws + WS_RQ); const bf16_t* RK = (const bf16_t*)(P.ws + WS_RK); const bf16_t* RV = (const bf16_t*)(P.ws + WS_RV);
    bf16_t* RG = (bf16_t*)(P.ws + WS_RG);
    unsigned char* Qs = lds; unsigned char* Ks = lds + 17408; unsigned char* KTs = lds + 34816; unsigned char* VTs = lds + 53248; float* OUTs = (float*)(lds + 90112);
    {
        const int n = t & 63; const bool live = n < CL;
        const float kdec = ex2((float)(CL - 1 - n) * lg2);
#pragma unroll
        for (int i = 0; i < 2; ++i) {
            const int dc = (t >> 6) + 8 * i;
            u32x4 kv = (u32x4){0u, 0u, 0u, 0u};
            if (live) kv = *(const u32x4*)(RK + (row0 + n) * 512 + head * 128 + dc * 8);
            if (OUT) {
                u32x4 qv = (u32x4){0u, 0u, 0u, 0u};
                if (live) qv = *(const u32x4*)(RQ + (row0 + n) * 512 + head * 128 + dc * 8);
                *(u32x4*)(Qs + n * 272 + dc * 16) = qv; *(u32x4*)(Ks + n * 272 + dc * 16) = kv;
            }
#pragma unroll
            for (int e = 0; e < 4; ++e) {
                const unsigned u = kv[e];
                *(bf16_t*)(KTs + (dc * 8 + 2 * e) * 144 + n * 2) = f2bf(bflo(u) * kdec);
                *(bf16_t*)(KTs + (dc * 8 + 2 * e + 1) * 144 + n * 2) = f2bf(bfhi(u) * kdec);
            }
        }
#pragma unroll
        for (int i = 0; i < 4; ++i) {
            const int vc = (t >> 6) + 8 * i;
            u32x4 vv = (u32x4){0u, 0u, 0u, 0u};
            if (live) vv = *(const u32x4*)(RV + (row0 + n) * 1024 + head * 256 + vc * 8);
#pragma unroll
            for (int e = 0; e < 4; ++e) {
                const unsigned u = vv[e];
                *(bf16_t*)(VTs + (vc * 8 + 2 * e) * 144 + n * 2) = (bf16_t)(u & 0xffffu);
                *(bf16_t*)(VTs + (vc * 8 + 2 * e + 1) * 144 + n * 2) = (bf16_t)(u >> 16);
            }
        }
    }
    __syncthreads();
    __builtin_amdgcn_sched_barrier(0);
    if (OUT) {
        f32x16 o[2]; o[0] = zero16(); o[1] = zero16();
#pragma unroll
        for (int db = 0; db < 4; ++db)
#pragma unroll
            for (int sp = 0; sp < 2; ++sp) {
                const bf16x8 bs = pack8(S[db], sp);
#pragma unroll
                for (int nbo = 0; nbo < 2; ++nbo) {
                    const unsigned char* qa = Qs + (32 * nbo + r) * 272 + (32 * db + 16 * sp + 4 * hh) * 2;
                    const bf16x8 a = cat4(*(const s16x4*)qa, *(const s16x4*)(qa + 16));
                    o[nbo] = MFMA(a, bs, o[nbo]);
                }
            }
        __builtin_amdgcn_sched_barrier(0);
#pragma unroll
        for (int nbo = 0; nbo < 2; ++nbo)
#pragma unroll
            for (int i = 0; i < 16; ++i) o[nbo][i] *= ex2((float)(32 * nbo + crow(i, hh) + 1) * lg2);
        __builtin_amdgcn_sched_barrier(0);
#pragma unroll
        for (int tix = 0; tix < 3; ++tix) {
            const int mb = (tix == 2) ? 1 : 0, nb = (tix == 0) ? 0 : 1;
            __builtin_amdgcn_sched_barrier(0);
            f32x16 x = zero16();
#pragma unroll
            for (int s = 0; s < 8; ++s) {
                const bf16x8 a = *(const bf16x8*)(Ks + (32 * mb + r) * 272 + (16 * s + 8 * hh) * 2);
                const bf16x8 b = *(const bf16x8*)(Qs + (32 * nb + r) * 272 + (16 * s + 8 * hh) * 2);
                x = MFMA(a, b, x);
            }
#pragma unroll
            for (int i = 0; i < 16; ++i) {
                const int d = (32 * nb + r) - (32 * mb + crow(i, hh));
                x[i] = (d >= 0) ? x[i] * ex2((float)d * lg2) : 0.f;
            }
#pragma unroll
            for (int sp = 0; sp < 2; ++sp) {
                const bf16x8 xa = pack8(x, sp);
                const unsigned char* va = VTs + (32 * w + r) * 144 + (32 * mb + 16 * sp + 4 * hh) * 2;
                const bf16x8 b = cat4(*(const s16x4*)va, *(const s16x4*)(va + 16));
                o[nb] = MFMA(xa, b, o[nb]);
            }
        }
        __builtin_amdgcn_sched_barrier(0);
#pragma unroll
        for (int nb = 0; nb < 2; ++nb)
#pragma unroll
            for (int i = 0; i < 16; ++i) OUTs[(32 * nb + crow(i, hh)) * 260 + 32 * w + r] = o[nb][i];
        __builtin_amdgcn_sched_barrier(0);
    }
    {
        const float gC = ex2((float)CL * lg2);
#pragma unroll
        for (int db = 0; db < 4; ++db) S[db] = S[db] * gC;
#pragma unroll
        for (int s = 0; s < 4; ++s) {
            const bf16x8 b = *(const bf16x8*)(VTs + (32 * w + r) * 144 + (16 * s + 8 * hh) * 2);
#pragma unroll
            for (int db = 0; db < 4; ++db) {
                const bf16x8 a = *(const bf16x8*)(KTs + (32 * db + r) * 144 + (16 * s + 8 * hh) * 2);
                S[db] = MFMA(a, b, S[db]);
            }
        }
    }
    __syncthreads();
    __builtin_amdgcn_sched_barrier(0);
    if (OUT) {
        const int n = t >> 3, sg = t & 7;
        f32x4 xv[8]; float s1 = 0.f, s2 = 0.f;
#pragma unroll
        for (int j = 0; j < 8; ++j) {
            xv[j] = *(const f32x4*)(OUTs + n * 260 + sg * 32 + 4 * j);
            s1 += (xv[j].x + xv[j].y) + (xv[j].z + xv[j].w);
            s2 += (xv[j].x * xv[j].x + xv[j].y * xv[j].y) + (xv[j].z * xv[j].z + xv[j].w * xv[j].w);
        }
#pragma unroll
        for (int o = 1; o < 8; o <<= 1) { s1 += __shfl_xor(s1, o); s2 += __shfl_xor(s2, o); }
        const float mean = s1 * (1.f / 256.f); const float var = fmaxf(s2 * (1.f / 256.f) - mean * mean, 0.f);
        const float rstd = frsq(var + EPS);
        if (n < CL) {
            bf16_t* gp = RG + (row0 + n) * 1024 + head * 256 + sg * 32;
            const float* gn = P.ret_gn_g + head * 256 + sg * 32;
            u32x4 gu[4];
#pragma unroll
            for (int j = 0; j < 4; ++j) gu[j] = *(const u32x4*)(gp + 8 * j);
#pragma unroll
            for (int j = 0; j < 4; ++j) {
                const f32x4 g0 = *(const f32x4*)(gn + 8 * j), g1 = *(const f32x4*)(gn + 8 * j + 4);
                const f32x4 xa = xv[2 * j], xb = xv[2 * j + 1];
                float y[8], gt[8];
                gt[0] = bflo(gu[j].x); gt[1] = bfhi(gu[j].x); gt[2] = bflo(gu[j].y); gt[3] = bfhi(gu[j].y); gt[4] = bflo(gu[j].z); gt[5] = bfhi(gu[j].z); gt[6] = bflo(gu[j].w); gt[7] = bfhi(gu[j].w);
                y[0] = (xa.x - mean) * rstd * g0.x; y[1] = (xa.y - mean) * rstd * g0.y; y[2] = (xa.z - mean) * rstd * g0.z; y[3] = (xa.w - mean) * rstd * g0.w;
                y[4] = (xb.x - mean) * rstd * g1.x; y[5] = (xb.y - mean) * rstd * g1.y; y[6] = (xb.z - mean) * rstd * g1.z; y[7] = (xb.w - mean) * rstd * g1.w;
#pragma unroll
                for (int e = 0; e < 8; ++e) y[e] *= gt[e] * frcp(1.f + ex2(-LOG2E * gt[e]));
                u32x4 ou; ou.x = pk2(y[0], y[1]); ou.y = pk2(y[2], y[3]); ou.z = pk2(y[4], y[5]); ou.w = pk2(y[6], y[7]);
                *(u32x4*)(gp + 8 * j) = ou;
            }
        }
    }
}

DI float head_lg2(int head) { return log2f(1.f - 1.f / (float)(32 << head)); }

DI void ret_passA_item(const Params& P, unsigned char* lds, int item) {
    const int bh = item / 12, g = item % 12, b = bh >> 2, head = bh & 3;
    const int t = opaque_tid(), w = t >> 6, lane = t & 63;
    const float lg2 = head_lg2(head);
    f32x16 S[4];
#pragma unroll
    for (int db = 0; db < 4; ++db) S[db] = zero16();
#pragma unroll 1
    for (int c = 0; c < 10; ++c) ret_chunk<false>(P, lds, S, (size_t)b * LP + 640 * g + 64 * c, 64, head, lg2);
    float* T = (float*)(P.ws + WS_TG) + ((size_t)item * 8 + w) * 4096;
#pragma unroll
    for (int db = 0; db < 4; ++db)
#pragma unroll
        for (int i = 0; i < 16; ++i) T[(db * 16 + i) * 64 + lane] = S[db][i];
}

DI void ret_passC_prompt(const Params& P, unsigned char* lds, int bh, int g) {
    const int b = bh >> 2, head = bh & 3;
    const int t = opaque_tid(), w = t >> 6, lane = t & 63, r = lane & 31, hh = lane >> 5;
    const float lg2 = head_lg2(head);
    f32x16 S[4];
#pragma unroll
    for (int db = 0; db < 4; ++db) S[db] = zero16();
    const float g640 = ex2(640.f * lg2);
#pragma unroll 1
    for (int gp = 0; gp < g; ++gp) {
        const float* T = (const float*)(P.ws + WS_TG) + ((size_t)(bh * 12 + gp) * 8 + w) * 4096;
#pragma unroll
        for (int db = 0; db < 4; ++db)
#pragma unroll
            for (int i = 0; i < 16; ++i) S[db][i] = S[db][i] * g640 + T[(db * 16 + i) * 64 + lane];
    }
#pragma unroll 1
    for (int c = 0; c < 10; ++c) ret_chunk<true>(P, lds, S, (size_t)b * LP + 640 * g + 64 * c, 64, head, lg2);
    if (g == 12) {
        float* dst = P.out + O_PST + (size_t)bh * 32768;
#pragma unroll
        for (int db = 0; db < 4; ++db)
#pragma unroll
            for (int i = 0; i < 16; ++i) dst[(32 * db + crow(i, hh)) * 256 + 32 * w + r] = S[db][i];
    }
    __syncthreads();
}

DI void ret_sample_item(const Params& P, unsigned char* lds, int sb, int head) {
    const int t = opaque_tid(), w = t >> 6, lane = t & 63, r = lane & 31, hh = lane >> 5;
    const float lg2 = head_lg2(head);
    const float* src = P.state_ret + (size_t)(sb * 4 + head) * 32768;
    f32x16 S[4];
#pragma unroll
    for (int db = 0; db < 4; ++db)
#pragma unroll
        for (int i = 0; i < 16; ++i) S[db][i] = src[(32 * db + crow(i, hh)) * 256 + 32 * w + r];
    ret_chunk<true>(P, lds, S, (size_t)MPR + sb * 32, 32, head, lg2);
    float* dst = P.out + O_SST + (size_t)(sb * 4 + head) * 32768;
#pragma unroll
    for (int db = 0; db < 4; ++db)
#pragma unroll
        for (int i = 0; i < 16; ++i) dst[(32 * db + crow(i, hh)) * 256 + 32 * w + r] = S[db][i];
    __syncthreads();
}

DI double wave_incl_scan(double v, int lane) {
#pragma unroll
    for (int o = 1; o < 64; o <<= 1) { const double u = __shfl_up(v, o); if (lane >= o) v += u; }
    return v;
}
DI void cumsum_seq(const Params& P, int seq, int lane) {
    if (seq < 32) {
        const int b = seq >> 3, h = seq & 7;
        const float* lf = (const float*)(P.ws + WS_LOGF) + (size_t)b * LP * 8 + h;
        float* nck = (float*)(P.ws + WS_NCKP) + (size_t)seq * LP;
        double loc = 0.0;
#pragma unroll 1
        for (int bt = 0; bt < 5; ++bt) {
            float v[26];
#pragma unroll
            for (int j = 0; j < 26; ++j) v[j] = lf[(size_t)(130 * lane + 26 * bt + j) * 8];
#pragma unroll
            for (int j = 0; j < 26; ++j) loc += (double)v[j];
        }
        const double inc = wave_incl_scan(loc, lane);
        double run = inc - loc;
#pragma unroll 1
        for (int bt = 0; bt < 5; ++bt) {
            float v[26];
#pragma unroll
            for (int j = 0; j < 26; ++j) v[j] = lf[(size_t)(130 * lane + 26 * bt + j) * 8];
#pragma unroll
            for (int j = 0; j < 26; ++j) { const int p = 130 * lane + 26 * bt + j; run += (double)v[j]; nck[p] = (p < VAL0) ? -1e30f : -(float)run; }
        }
    } else {
        const int s = seq - 32, sb = s >> 3, h = s & 7;
        const float* cl = P.cache_logf + (size_t)sb * 4096 * 8 + h;
        float* nck = (float*)(P.ws + WS_NCKS) + (size_t)s * 4128;
        double loc = 0.0;
#pragma unroll 1
        for (int bt = 0; bt < 4; ++bt) {
            float v[16];
#pragma unroll
            for (int j = 0; j < 16; ++j) v[j] = cl[(size_t)(64 * lane + 16 * bt + j) * 8];
#pragma unroll
            for (int j = 0; j < 16; ++j) loc += (double)v[j];
        }
        const double inc = wave_incl_scan(loc, lane);
        double run = inc - loc;
#pragma unroll 1
        for (int bt = 0; bt < 4; ++bt) {
            float v[16];
#pragma unroll
            for (int j = 0; j < 16; ++j) v[j] = cl[(size_t)(64 * lane + 16 * bt + j) * 8];
#pragma unroll
            for (int j = 0; j < 16; ++j) { const int p = 64 * lane + 16 * bt + j; run += (double)v[j]; nck[p] = -(float)run; }
        }
        const double tot = __shfl(inc, 63);
        const float* lf = (const float*)(P.ws + WS_LOGF) + ((size_t)MPR + sb * 32) * 8 + h;
        const double mine = (lane < 32) ? (double)lf[(size_t)lane * 8] : 0.0;
        const double inc2 = wave_incl_scan(mine, lane);
        if (lane < 32) nck[4096 + lane] = -(float)(tot + inc2);
    }
}

DI void phase_p2(const Params& P, unsigned char* lds) {
    constexpr int NRET = 192, NCUM = 12;
    for (int it = blockIdx.x; it < NRET + NCUM; it += gridDim.x) {
        if (it < NRET) { ret_passA_item(P, lds, it); __syncthreads(); }
        else { const int seq = (it - NRET) * 8 + (threadIdx.x >> 6); cumsum_seq(P, seq, threadIdx.x & 63); }
    }
}

DI void attn_prompt_item(const Params& P, unsigned char* lds, int b, int head, int qb, float qkb2) {
    const int t = opaque_tid(), w = t >> 6, lane = t & 63, r = lane & 31, hh = lane >> 5;
    const bf16_t* FK = (const bf16_t*)(P.ws + WS_FK); const bf16_t* VT = (const bf16_t*)(P.ws + WS_VT); bf16_t* FQ = (bf16_t*)(P.ws + WS_FQ);
    const float* NCK = (const float*)(P.ws + WS_NCKP) + (size_t)(b * 8 + head) * LP;
    const int q0 = OFF + 256 * qb, qw0 = q0 + 32 * w, myq = qw0 + r;
    const float cref = -NCK[q0];
    bf16_t* qp = FQ + ((size_t)b * LP + myq) * 1024 + head * 128;
    bf16x8 qf[8];
#pragma unroll
    for (int s = 0; s < 8; ++s) qf[s] = *(const bf16x8*)(qp + 16 * s + 8 * hh);
    f32x16 o[4];
#pragma unroll
    for (int db = 0; db < 4; ++db) o[db] = zero16();
    float m_run = -1e30f, l_run = 0.f;
    const int kt_last = (q0 + 255) >> 6;
    constexpr int BUF = 36864, VOFF = 17408, BOFF = 35840, WMOFF = 3 * BUF;
    const int kkey = t >> 4, kdc = t & 15;
    const int vd = t >> 3, vkc = t & 7;
    const bf16_t* kg = FK + ((size_t)b * LP + kkey) * 1024 + head * 128 + kdc * 8;
    const bf16_t* vg = VT + ((size_t)((b * 8 + head) * 128 + vd)) * LP + vkc * 8;
    u32x4 kr[2], vr[2]; float br = 0.f;
#define ATT_GLOAD(KT) do { const int kbase_ = (KT) * 64; \
        kr[0] = *(const u32x4*)(kg + (size_t)kbase_ * 1024); kr[1] = *(const u32x4*)(kg + (size_t)(kbase_ + 32) * 1024); \
        vr[0] = *(const u32x4*)(vg + kbase_); vr[1] = *(const u32x4*)(vg + (size_t)64 * LP + kbase_); \
        if (t < 64) br = (NCK[kbase_ + t] + cref) * LOG2E; } while (0)
#define ATT_SWRITE(BI) do { unsigned char* sb_ = lds + (BI) * BUF; \
        *(u32x4*)(sb_ + kkey * 272 + kdc * 16) = kr[0]; *(u32x4*)(sb_ + (kkey + 32) * 272 + kdc * 16) = kr[1]; \
        *(u32x4*)(sb_ + VOFF + vd * 144 + vkc * 16) = vr[0]; *(u32x4*)(sb_ + VOFF + (vd + 64) * 144 + vkc * 16) = vr[1]; \
        if (t < 64) *(float*)(sb_ + BOFF + t * 4) = br; } while (0)
#define ATT_PV(SBV, PP) do { _Pragma("unroll") for (int kb_ = 0; kb_ < 2; ++kb_) _Pragma("unroll") for (int sp_ = 0; sp_ < 2; ++sp_) _Pragma("unroll") for (int db_ = 0; db_ < 4; ++db_) { \
        const unsigned char* va_ = (SBV) + VOFF + (32 * db_ + r) * 144 + (32 * kb_ + 16 * sp_ + 4 * hh) * 2; \
        o[db_] = MFMA(cat4(*(const s16x4*)va_, *(const s16x4*)(va_ + 16)), PP[kb_][sp_], o[db_]); } } while (0)
    float* WM = (float*)(lds + WMOFF);
    if (t < 16) WM[t] = -1e30f;
    ATT_GLOAD(kt_last); ATT_SWRITE(kt_last % 3);
    __syncthreads();
    const bool late = __builtin_amdgcn_readfirstlane(w) >= 4;
    bf16x8 pp[2][2]; bool pending = false; int pbuf = 0;
#pragma unroll 1
    for (int kt = kt_last; kt >= 1; --kt) {
        const int bi = kt % 3;
        const unsigned char* sb = lds + bi * BUF;
        {
            const f32x4 w0 = *(const f32x4*)(WM + ((kt + 1) & 1) * 8), w1 = *(const f32x4*)(WM + ((kt + 1) & 1) * 8 + 4);
            const float mfloor = fminf(fminf(fminf(w0.x, w0.y), fminf(w0.z, w0.w)), fminf(fminf(w1.x, w1.y), fminf(w1.z, w1.w)));
            const float blast = *(const float*)(sb + BOFF + 63 * 4);
            if (blast + qkb2 < mfloor - 32.f) break;
        }
        const bool more = kt > 1;
        if (more) ATT_GLOAD(kt - 1);
        if (pending) { ATT_PV(lds + pbuf * BUF, pp); pending = false; }
        float wmin = -1e30f;
        if (kt * 64 <= qw0 + 31) {
            f32x16 st[2];
#pragma unroll
            for (int kb = 0; kb < 2; ++kb) {
                st[kb] = zero16();
#pragma unroll
                for (int s = 0; s < 8; ++s) {
                    const bf16x8 a = *(const bf16x8*)(sb + (32 * kb + r) * 272 + (16 * s + 8 * hh) * 2);
                    st[kb] = MFMA(a, qf[s], st[kb]);
                }
            }
            const bool need_mask = (kt * 64 + 63 > qw0);
            float mx = -1e30f;
#pragma unroll
            for (int kb = 0; kb < 2; ++kb)
#pragma unroll
                for (int g = 0; g < 4; ++g) {
                    const f32x4 bz = *(const f32x4*)(sb + BOFF + (32 * kb + 8 * g + 4 * hh) * 4);
#pragma unroll
                    for (int e = 0; e < 4; ++e) {
                        float v = st[kb][4 * g + e] * ATT_SC + bz[e];
                        if (need_mask) { const int key = kt * 64 + 32 * kb + 8 * g + 4 * hh + e; v = (key > myq) ? -1e30f : v; }
                        st[kb][4 * g + e] = v; mx = fmaxf(mx, v);
                    }
                }
            mx = fmaxf(mx, __shfl_xor(mx, 32));
            const float m_new = fmaxf(m_run, mx);
            const bool grew = __builtin_amdgcn_ballot_w64(m_new > m_run) != 0ull;
            float ps = 0.f;
#pragma unroll
            for (int kb = 0; kb < 2; ++kb)
#pragma unroll
                for (int i = 0; i < 16; ++i) { const float pv = ex2(st[kb][i] - m_new); st[kb][i] = pv; ps += pv; }
            if (grew) {
                const float alpha = ex2(m_run - m_new); m_run = m_new;
                l_run = l_run * alpha;
#pragma unroll
                for (int db = 0; db < 4; ++db) o[db] = o[db] * alpha;
            }
            l_run += ps;
#pragma unroll
            for (int kb = 0; kb < 2; ++kb)
#pragma unroll
                for (int sp = 0; sp < 2; ++sp) pp[kb][sp] = pack8(st[kb], sp);
            if (late) { pending = true; pbuf = bi; }
            else ATT_PV(sb, pp);
            wmin = m_run;
#pragma unroll
            for (int of = 1; of < 32; of <<= 1) wmin = fminf(wmin, __shfl_xor(wmin, of));
        }
        if (lane == 0) WM[(kt & 1) * 8 + w] = wmin;
        if (more) ATT_SWRITE((kt - 1) % 3);
        __syncthreads();
    }
    if (pending) ATT_PV(lds + pbuf * BUF, pp);
#undef ATT_GLOAD
#undef ATT_SWRITE
#undef ATT_PV
    const float lt = l_run + __shfl_xor(l_run, 32);
    const float inv = frcp(lt);
#pragma unroll
    for (int db = 0; db < 4; ++db)
#pragma unroll
        for (int g = 0; g < 4; ++g) {
            u32x2 ov; ov.x = pk2(o[db][4 * g] * inv, o[db][4 * g + 1] * inv); ov.y = pk2(o[db][4 * g + 2] * inv, o[db][4 * g + 3] * inv);
            *(u32x2*)(qp + 32 * db + 8 * g + 4 * hh) = ov;
        }
}

DI void attn_sample_item(const Params& P, unsigned char* lds, int sb, int head) {
    const int t = opaque_tid(), w = t >> 6, lane = t & 63, r = lane & 31, hh = lane >> 5;
    bf16_t* FQ = (bf16_t*)(P.ws + WS_FQ);
    const float* NCK = (const float*)(P.ws + WS_NCKS) + (size_t)(sb * 8 + head) * 4128;
    const float cref = -NCK[4096];
    bf16_t* qrow = FQ + ((size_t)MPR + sb * 32) * 1024 + head * 128;
    bf16x8 qf[8];
#pragma unroll
    for (int s = 0; s < 8; ++s) qf[s] = *(const bf16x8*)(qrow + (size_t)r * 1024 + 16 * s + 8 * hh);
    f32x16 o[4];
#pragma unroll
    for (int db = 0; db < 4; ++db) o[db] = zero16();
    float m_run = -1e30f, l_run = 0.f;
#pragma unroll 1
    for (int tile = w; tile < 129; tile += 8) {
        const float *kbase, *vbase;
        if (tile < 128) { const size_t off = ((size_t)sb * 4096 + 32 * tile) * 1024 + head * 128; kbase = P.cache_k + off; vbase = P.cache_v + off; }
        else { const size_t off = (size_t)sb * 32 * 1024 + head * 128; kbase = P.out + O_SK + off; vbase = P.out + O_SV + off; }
        f32x16 st = zero16();
#pragma unroll
        for (int s = 0; s < 8; ++s) {
            const float* kp = kbase + (size_t)r * 1024 + 16 * s + 8 * hh;
            const f32x4 k0 = *(const f32x4*)kp, k1 = *(const f32x4*)(kp + 4);
            u32x4 pk; pk.x = pk2(k0.x, k0.y); pk.y = pk2(k0.z, k0.w); pk.z = pk2(k1.x, k1.y); pk.w = pk2(k1.z, k1.w);
            st = MFMA(__builtin_bit_cast(bf16x8, pk), qf[s], st);
        }
        float mx = -1e30f;
#pragma unroll
        for (int g = 0; g < 4; ++g) {
            const f32x4 bz = *(const f32x4*)(NCK + 32 * tile + 8 * g + 4 * hh);
#pragma unroll
            for (int e = 0; e < 4; ++e) {
                float v = st[4 * g + e] * ATT_SC + (bz[e] + cref) * LOG2E;
                if (tile == 128) { const int key = 8 * g + 4 * hh + e; v = (key > r) ? -1e30f : v; }
                st[4 * g + e] = v; mx = fmaxf(mx, v);
            }
        }
        mx = fmaxf(mx, __shfl_xor(mx, 32));
        const float m_new = fmaxf(m_run, mx);
        const float alpha = ex2(m_run - m_new); m_run = m_new;
        float ps = 0.f;
#pragma unroll
        for (int i = 0; i < 16; ++i) { const float pv = ex2(st[i] - m_new); st[i] = pv; ps += pv; }
        l_run = l_run * alpha + ps;
#pragma unroll
        for (int db = 0; db < 4; ++db) o[db] = o[db] * alpha;
#pragma unroll
        for (int sp = 0; sp < 2; ++sp) {
            const bf16x8 pb = pack8(st, sp);
#pragma unroll
            for (int db = 0; db < 4; ++db) {
                const float* vp = vbase + (size_t)(16 * sp + 4 * hh) * 1024 + 32 * db + r;
                float f[8];
#pragma unroll
                for (int j = 0; j < 8; ++j) f[j] = vp[(size_t)((j & 3) + 8 * (j >> 2)) * 1024];
                u32x4 pk; pk.x = pk2(f[0], f[1]); pk.y = pk2(f[2], f[3]); pk.z = pk2(f[4], f[5]); pk.w = pk2(f[6], f[7]);
                o[db] = MFMA(__builtin_bit_cast(bf16x8, pk), pb, o[db]);
            }
        }
    }
    const float lt = l_run + __shfl_xor(l_run, 32);
    float* Ol = (float*)lds; float* ML = (float*)(lds + 131072);
#pragma unroll
    for (int db = 0; db < 4; ++db)
#pragma unroll
        for (int i = 0; i < 16; ++i) Ol[(w * 128 + 32 * db + crow(i, hh)) * 32 + r] = o[db][i];
    if (hh == 0) { ML[(w * 32 + r) * 2] = m_run; ML[(w * 32 + r) * 2 + 1] = lt; }
    __syncthreads();
    {
        const int q = t & 31, dg = t >> 5;
        float M = -1e30f;
#pragma unroll
        for (int ww = 0; ww < 8; ++ww) M = fmaxf(M, ML[(ww * 32 + q) * 2]);
        float L = 0.f, a[8];
#pragma unroll
        for (int e = 0; e < 8; ++e) a[e] = 0.f;
#pragma unroll
        for (int ww = 0; ww < 8; ++ww) {
            const float f = ex2(ML[(ww * 32 + q) * 2] - M); L += ML[(ww * 32 + q) * 2 + 1] * f;
#pragma unroll
            for (int e = 0; e < 8; ++e) a[e] += Ol[(ww * 128 + dg * 8 + e) * 32 + q] * f;
        }
        const float inv = frcp(L);
        u32x4 ov; ov.x = pk2(a[0] * inv, a[1] * inv); ov.y = pk2(a[2] * inv, a[3] * inv); ov.z = pk2(a[4] * inv, a[5] * inv); ov.w = pk2(a[6] * inv, a[7] * inv);
        *(u32x4*)(qrow + (size_t)q * 1024 + dg * 8) = ov;
    }
    __syncthreads();
}

DI void phase_p3(const Params& P, unsigned char* lds) {
    constexpr int N_RETP = 208, N_RETS = 32, N_AS = 64, N_AP = 1024;
    constexpr int NITEMS = N_RETP + N_RETS + N_AS + N_AP;
    int* s_item = (int*)(lds + LDS_BYTES - 16);
    unsigned* ctr = (unsigned*)(P.ws + WS_CTL);
    float qkb2;
    {
        const int lane = threadIdx.x & 63;
        float gq = fmaxf(fabsf(P.q_norm_g[lane]), fabsf(P.q_norm_g[lane + 64])), gk = fmaxf(fabsf(P.k_norm_g[lane]), fabsf(P.k_norm_g[lane + 64]));
#pragma unroll
        for (int o = 1; o < 64; o <<= 1) { gq = fmaxf(gq, __shfl_xor(gq, o)); gk = fmaxf(gk, __shfl_xor(gk, o)); }
        qkb2 = 128.f * gq * gk * 1.02f * ATT_SC;
    }
    for (;;) {
        if (threadIdx.x == 0) *s_item = (int)atomicAdd(ctr, 1u);
        __syncthreads();
        int it = *s_item;
        __syncthreads();
        if (it >= NITEMS) break;
        if (it < 256) { const int head = 7 - (it >> 7), rem = it & 127; attn_prompt_item(P, lds, rem & 3, head, 31 - (rem >> 2), qkb2); continue; } it -= 256;
        if (it < N_RETP) { ret_passC_prompt(P, lds, it / 13, it % 13); continue; } it -= N_RETP;
        if (it < N_RETS) { ret_sample_item(P, lds, it >> 2, it & 3); continue; } it -= N_RETS;
        if (it < N_AS) { attn_sample_item(P, lds, it >> 3, it & 7); continue; } it -= N_AS;
        { const int head = 5 - (it >> 7), rem = it & 127; attn_prompt_item(P, lds, rem & 3, head, 31 - (rem >> 2), qkb2); }
    }
}

DI void light_grid_barrier(unsigned* ctl, unsigned seam) {
    __syncthreads();
    if (threadIdx.x == 0) {
        const unsigned g = blockIdx.x & 7u, gs = (gridDim.x - g + 7u) >> 3, ng = gridDim.x < 8u ? gridDim.x : 8u;
        __threadfence();
        const unsigned old = __hip_atomic_fetch_add(ctl + 64 + 32 * g, 1u, __ATOMIC_RELAXED, __HIP_MEMORY_SCOPE_AGENT);
        if (old == seam * gs + gs - 1u) {
            __threadfence();
            const unsigned oldt = __hip_atomic_fetch_add(ctl + 32, 1u, __ATOMIC_RELAXED, __HIP_MEMORY_SCOPE_AGENT);
            if (oldt == seam * ng + ng - 1u) {
                __threadfence();
                for (unsigned j = 0; j < ng; ++j) __hip_atomic_store(ctl + 320 + 32 * j, seam + 1u, __ATOMIC_RELAXED, __HIP_MEMORY_SCOPE_AGENT);
            }
        }
        while (__hip_atomic_load(ctl + 320 + 32 * g, __ATOMIC_RELAXED, __HIP_MEMORY_SCOPE_AGENT) < seam + 1u) __builtin_amdgcn_s_sleep(16);
        __threadfence();
    }
    __syncthreads();
}

__global__ void __launch_bounds__(512) mega_fwd(Params P) {
    extern __shared__ __attribute__((aligned(16))) unsigned char lds[];
    cg::grid_group grid = cg::this_grid();
#define RUN_PHASE(K, BODY) do { if (P.ph_lo <= (K) && (K) < P.ph_hi) { BODY; if (P.coop && (K) + 1 < P.ph_hi) { if ((K) == 0) grid.sync(); else light_grid_barrier((unsigned*)(P.ws + WS_CTL), (unsigned)(K) - 1u); } } } while (0)
    RUN_PHASE(0, (p0_rows(P, lds), p0_weights(P, lds, 0), p0_misc(P)));
    RUN_PHASE(1, (phase_p1(P, lds), p0_weights(P, lds, 1)));
    RUN_PHASE(2, phase_p2(P, lds));
    RUN_PHASE(3, phase_p3(P, lds));
    RUN_PHASE(4, phase_p4(P, lds));
    RUN_PHASE(5, phase_p5(P, lds));
    RUN_PHASE(6, phase_p6(P, lds));
    RUN_PHASE(7, phase_p7(P, lds));
#undef RUN_PHASE
}

extern "C" void kernel_launch(void* const* d_in, const int* in_sizes, int n_in, void* d_out, int out_size, void* d_ws, size_t ws_size, hipStream_t stream) {
    static int grid_blocks = 0;
    if (!grid_blocks) {
        int dev = 0, cus = 0, per_cu = 0;
        (void)hipGetDevice(&dev);
        (void)hipDeviceGetAttribute(&cus, hipDeviceAttributeMultiprocessorCount, dev);
        (void)hipFuncSetAttribute((const void*)mega_fwd, hipFuncAttributeMaxDynamicSharedMemorySize, LDS_BYTES);
        (void)hipOccupancyMaxActiveBlocksPerMultiprocessor(&per_cu, (const void*)mega_fwd, 512, LDS_BYTES);
        if (per_cu < 1) { fprintf(stderr, "kernel_launch: occupancy query returned %d\n", per_cu); per_cu = 1; }
        grid_blocks = cus * per_cu;
        if (ws_size < WS_END) fprintf(stderr, "kernel_launch: workspace too small: %zu < %zu\n", ws_size, (size_t)WS_END);
        (void)hipGetLastError();
    }
    Params p{};
    p.x_prompt = (const float*)d_in[0]; p.x_sample = (const float*)d_in[1]; p.state_ret = (const float*)d_in[2]; p.cache_k = (const float*)d_in[3];
    p.cache_v = (const float*)d_in[4]; p.cache_logf = (const float*)d_in[5]; p.meta = (const float*)d_in[6]; p.norm1_g = (const float*)d_in[7];
    p.w_in = (const float*)d_in[8]; p.b_forget = (const float*)d_in[9]; p.q_norm_g = (const float*)d_in[10]; p.k_norm_g = (const float*)d_in[11];
    p.ret_gn_g = (const float*)d_in[12]; p.w_ret_out = (const float*)d_in[13]; p.w_fox_out = (const float*)d_in[14]; p.w_o = (const float*)d_in[15];
    p.norm2_g = (const float*)d_in[16]; p.w_ff1 = (const float*)d_in[17]; p.w_ff2 = (const float*)d_in[18];
    p.out = (float*)d_out; p.ws = (unsigned char*)d_ws; p.pad = 0;
#if MULTI_LAUNCH
    for (int ph = 0; ph < 8; ++ph) {
        p.ph_lo = ph; p.ph_hi = ph + 1; p.coop = 0;
        hipLaunchKernelGGL(mega_fwd, dim3(grid_blocks), dim3(512), LDS_BYTES, stream, p);
    }
#else
    p.ph_lo = 0; p.ph_hi = 8; p.coop = 1;
    void* args[] = {&p};
    hipError_t e = hipLaunchCooperativeKernel((void*)mega_fwd, dim3(grid_blocks), dim3(512), args, LDS_BYTES, stream);
    if (e != hipSuccess) fprintf(stderr, "cooperative launch failed: %s (grid %d)\n", hipGetErrorString(e), grid_blocks);
#endif
}
```

```cpp
#include <hip/hip_runtime.h>
#include <hip/hip_cooperative_groups.h>
#include <cstdio>
#include <cstdint>
namespace cg = cooperative_groups;

#ifndef MULTI_LAUNCH
#define MULTI_LAUNCH 0
#endif

typedef short bf16x8 __attribute__((ext_vector_type(8)));
typedef short s16x4 __attribute__((ext_vector_type(4)));
typedef float f32x16 __attribute__((ext_vector_type(16)));
typedef float f32x4 __attribute__((ext_vector_type(4)));
typedef float f32x2 __attribute__((ext_vector_type(2)));
typedef unsigned u32x4 __attribute__((ext_vector_type(4)));
typedef unsigned u32x2 __attribute__((ext_vector_type(2)));
typedef __bf16 bf2_t __attribute__((ext_vector_type(2)));
typedef unsigned short bf16_t;
#define DI __device__ __forceinline__
#define MFMA(a, b, c) __builtin_amdgcn_mfma_f32_32x32x16_bf16((a), (b), (c), 0, 0, 0)

constexpr int D = 1024, LP = 8320, OFF = 128, VAL0 = 112, MPR = 33280, MT = 33536, INW = 8200, DFF = 4096;
constexpr int NTM = MT / 256;
constexpr float EPS = 1e-6f, LOG2E = 1.4426950408889634f;
constexpr float ATT_SC = 0.08838834764831845f * 1.4426950408889634f;
constexpr int LDS_BYTES = 163840;

constexpr size_t SZ_ACT = (size_t)MT * 1024 * 2;
constexpr size_t WS_CTL = 0;
constexpr size_t WS_XN = 4096;
constexpr size_t WS_WIN = WS_XN + SZ_ACT;
constexpr size_t WS_WRET = WS_WIN + (size_t)8192 * 1024 * 2;
constexpr size_t WS_WFOX = WS_WRET + 2097152;
constexpr size_t WS_WO = WS_WFOX + 2097152;
constexpr size_t WS_WFF1 = WS_WO + 2097152;
constexpr size_t WS_WFF2 = WS_WFF1 + 8388608;
constexpr size_t WS_RQ = WS_WFF2 + 8388608;
constexpr size_t WS_RK = WS_RQ + SZ_ACT / 2;
constexpr size_t WS_RV = WS_RK + SZ_ACT / 2;
constexpr size_t WS_RG = WS_RV + SZ_ACT;
constexpr size_t WS_FQ = WS_RG + SZ_ACT;
constexpr size_t WS_FK = WS_FQ + SZ_ACT;
constexpr size_t WS_VT = WS_FK + SZ_ACT;
constexpr size_t WS_LOGF = WS_VT + (size_t)4 * 8 * 128 * LP * 2;
constexpr size_t WS_NCKP = WS_LOGF + (size_t)MT * 8 * 4;
constexpr size_t WS_NCKS = WS_NCKP + (size_t)32 * LP * 4;
constexpr size_t WS_ROPE = WS_NCKS + (size_t)64 * 4128 * 4;
constexpr size_t WS_SSQ = WS_ROPE + (size_t)LP * 64 * 8;
constexpr size_t WS_GAS = WS_SSQ + (size_t)MT * 8 * 4;
constexpr size_t WS_GBS = WS_GAS + 524288;
constexpr size_t WS_SSQS = WS_GBS + 524288;
constexpr size_t WS_END = WS_SSQS + 32768;
constexpr size_t WS_TG = WS_XN;
constexpr size_t WS_M = WS_RV;
constexpr size_t WS_A2 = WS_FK;
constexpr size_t WS_U = WS_RQ;
static_assert(WS_END <= (size_t)512 * 1024 * 1024, "workspace too large");
static_assert(WS_U + (size_t)MT * 4096 * 2 == WS_FK, "U alias");

constexpr size_t O_Y = 0, O_YS = 33554432, O_PST = O_YS + 262144, O_PK = O_PST + 524288, O_PV = O_PK + 33619968, O_PLF = O_PV + 33619968,
                 O_SST = O_PLF + 262656, O_SK = O_SST + 1048576, O_SV = O_SK + 262144, O_SLF = O_SV + 262144;

struct Params {
    const float* x_prompt; const float* x_sample; const float* state_ret; const float* cache_k; const float* cache_v; const float* cache_logf;
    const float* meta; const float* norm1_g; const float* w_in; const float* b_forget; const float* q_norm_g; const float* k_norm_g; const float* ret_gn_g;
    const float* w_ret_out; const float* w_fox_out; const float* w_o; const float* norm2_g; const float* w_ff1; const float* w_ff2;
    float* out; unsigned char* ws; int ph_lo, ph_hi, coop, pad;
};

DI unsigned pk2(float a, float b) { f32x2 v = {a, b}; bf2_t r = __builtin_convertvector(v, bf2_t); return __builtin_bit_cast(unsigned, r); }
DI bf16_t f2bf(float a) { return (bf16_t)(pk2(a, 0.f) & 0xffffu); }
DI float bflo(unsigned u) { return __uint_as_float(u << 16); }
DI float bfhi(unsigned u) { return __uint_as_float(u & 0xffff0000u); }
DI float bf2f(bf16_t u) { return __uint_as_float(((unsigned)u) << 16); }
DI int crow(int i, int h) { return (i & 3) + 8 * (i >> 2) + 4 * h; }
DI float ex2(float x) { return __builtin_amdgcn_exp2f(x); }
DI float frcp(float x) { return __builtin_amdgcn_rcpf(x); }
DI float frsq(float x) { return __builtin_amdgcn_rsqf(x); }
DI bf16x8 pack8(const f32x16& x, int s) {
    u32x4 p; p.x = pk2(x[8 * s], x[8 * s + 1]); p.y = pk2(x[8 * s + 2], x[8 * s + 3]); p.z = pk2(x[8 * s + 4], x[8 * s + 5]); p.w = pk2(x[8 * s + 6], x[8 * s + 7]);
    return __builtin_bit_cast(bf16x8, p);
}
DI bf16x8 cat4(s16x4 lo, s16x4 hi) { return __builtin_shufflevector(lo, hi, 0, 1, 2, 3, 4, 5, 6, 7); }
DI float wave_sum(float v) {
#pragma unroll
    for (int o = 1; o < 64; o <<= 1) v += __shfl_xor(v, o);
    return v;
}
DI float half_sum32(float v) {
#pragma unroll
    for (int o = 1; o < 32; o <<= 1) v += __shfl_xor(v, o);
    return v;
}
DI void decode_row(int r, int& samp, int& b, int& p) {
    if (r < MPR) { samp = 0; b = r / LP; p = r - b * LP; } else { samp = 1; const int s = r - MPR; b = s >> 5; p = s & 31; }
}
DI int opaque_tid() { int t = threadIdx.x; asm volatile("" : "+v"(t)); return t; }
DI f32x16 zero16() { f32x16 z; for (int i = 0; i < 16; ++i) z[i] = 0.f; return z; }

DI void p0_rows(const Params& P, unsigned char* lds) {
    float* wffT = (float*)lds;
    const int t = opaque_tid();
#pragma unroll
    for (int i = 0; i < 16; ++i) { const int idx = t + 512 * i; const int c = idx >> 3, h = idx & 7; wffT[h * 1024 + c] = P.w_in[(size_t)c * INW + 6144 + h]; }
    __syncthreads();
    const int lane = t & 63, wave = t >> 6;
    bf16_t* XN = (bf16_t*)(P.ws + WS_XN); float* LOGF = (float*)(P.ws + WS_LOGF);
    for (int r = blockIdx.x * 8 + wave; r < MT; r += gridDim.x * 8) {
        int samp, b, p; decode_row(r, samp, b, p);
        const float* src = nullptr;
        if (samp) src = P.x_sample + (size_t)(r - MPR) * D;
        else if (p >= OFF) src = P.x_prompt + ((size_t)b * 8192 + (p - OFF)) * D;
        else if (p >= VAL0) src = P.meta + (size_t)(p - VAL0) * D;
        f32x4 v[4]; float ss = 0.f;
#pragma unroll
        for (int j = 0; j < 4; ++j) {
            if (src) v[j] = *(const f32x4*)(src + 4 * lane + 256 * j); else v[j] = (f32x4){0.f, 0.f, 0.f, 0.f};
            ss += v[j].x * v[j].x + v[j].y * v[j].y + v[j].z * v[j].z + v[j].w * v[j].w;
        }
        ss = wave_sum(ss);
        const float rstd = frsq(ss * (1.f / 1024.f) + EPS);
        float dot[8];
#pragma unroll
        for (int h = 0; h < 8; ++h) dot[h] = 0.f;
#pragma unroll
        for (int j = 0; j < 4; ++j) {
            const f32x4 g = *(const f32x4*)(P.norm1_g + 4 * lane + 256 * j);
            v[j] = v[j] * rstd * g;
            u32x2 o; o.x = pk2(v[j].x, v[j].y); o.y = pk2(v[j].z, v[j].w);
            *(u32x2*)(XN + (size_t)r * D + 4 * lane + 256 * j) = o;
#pragma unroll
            for (int h = 0; h < 8; ++h) { const f32x4 w = *(const f32x4*)(wffT + h * 1024 + 4 * lane + 256 * j); dot[h] += v[j].x * w.x + v[j].y * w.y + v[j].z * w.z + v[j].w * w.w; }
        }
#pragma unroll
        for (int h = 0; h < 8; ++h) dot[h] = wave_sum(dot[h]);
        float mine = dot[0];
#pragma unroll
        for (int h = 1; h < 8; ++h) mine = (lane == h) ? dot[h] : mine;
        if (lane < 8) {
            const float vv = mine + P.b_forget[lane];
            float lf = fminf(vv, 0.f) - log1pf(__expf(-fabsf(vv)));
            if (!samp && p < VAL0) lf = 0.f;
            LOGF[(size_t)r * 8 + lane] = lf;
            if (samp) P.out[O_SLF + (size_t)(r - MPR) * 8 + lane] = lf;
            else if (p >= VAL0) P.out[O_PLF + ((size_t)b * 8208 + (p - VAL0)) * 8 + lane] = lf;
        }
    }
    __syncthreads();
}

DI void transpose_item(const float* W, int ldw, int col0, int K, bf16_t* WT, int n0, int k0, float* tile) {
    const int t = opaque_tid(); const int nn = t & 63, kb = t >> 6;
#pragma unroll
    for (int i = 0; i < 8; ++i) { const int kk = kb + 8 * i; tile[kk * 65 + nn] = W[(size_t)(k0 + kk) * ldw + col0 + nn]; }
    __syncthreads();
    const int n = t >> 3, kc = t & 7;
    float f[8];
#pragma unroll
    for (int e = 0; e < 8; ++e) f[e] = tile[(8 * kc + e) * 65 + n];
    u32x4 o; o.x = pk2(f[0], f[1]); o.y = pk2(f[2], f[3]); o.z = pk2(f[4], f[5]); o.w = pk2(f[6], f[7]);
    *(u32x4*)(WT + (size_t)(n0 + n) * K + k0 + 8 * kc) = o;
    __syncthreads();
}

DI void p0_weights(const Params& P, unsigned char* lds) {
    float* tile = (float*)lds;
    constexpr int I0 = 16 * 128, I1 = 256, I4 = 16 * 64, I5 = 64 * 16;
    constexpr int NIT = I0 + 3 * I1 + I4 + I5;
    for (int it = blockIdx.x; it < NIT; it += gridDim.x) {
        int r = it;
        if (r < I0) { const int kt = r / 128, nt = r % 128; const int n0 = nt * 64; transpose_item(P.w_in, INW, n0 + (n0 >= 6144 ? 8 : 0), 1024, (bf16_t*)(P.ws + WS_WIN), n0, kt * 64, tile); continue; } r -= I0;
        if (r < I1) { transpose_item(P.w_ret_out, 1024, (r % 16) * 64, 1024, (bf16_t*)(P.ws + WS_WRET), (r % 16) * 64, (r / 16) * 64, tile); continue; } r -= I1;
        if (r < I1) { transpose_item(P.w_fox_out, 1024, (r % 16) * 64, 1024, (bf16_t*)(P.ws + WS_WFOX), (r % 16) * 64, (r / 16) * 64, tile); continue; } r -= I1;
        if (r < I1) { transpose_item(P.w_o, 1024, (r % 16) * 64, 1024, (bf16_t*)(P.ws + WS_WO), (r % 16) * 64, (r / 16) * 64, tile); continue; } r -= I1;
        if (r < I4) { transpose_item(P.w_ff1, 4096, (r % 64) * 64, 1024, (bf16_t*)(P.ws + WS_WFF1), (r % 64) * 64, (r / 64) * 64, tile); continue; } r -= I4;
        transpose_item(P.w_ff2, 1024, (r % 16) * 64, 4096, (bf16_t*)(P.ws + WS_WFF2), (r % 16) * 64, (r / 16) * 64, tile);
    }
}

DI void p0_misc(const Params& P) {
    f32x2* ROPE = (f32x2*)(P.ws + WS_ROPE);
    for (int idx = blockIdx.x * 512 + threadIdx.x; idx < LP * 64; idx += gridDim.x * 512) {
        const int pp = idx >> 6, c = idx & 63;
        const float pos = (float)(pp - 128);
        const float inv = exp2f(-(float)c * (13.287712379549449f / 64.f));
        const float ang = pos * inv;
        double td = (double)ang * 0.15915494309189535; td -= __builtin_rint(td);
        const float tf = (float)td;
        f32x2 cs; cs.x = __builtin_amdgcn_cosf(tf); cs.y = __builtin_amdgcn_sinf(tf);
        ROPE[idx] = cs;
    }
}

#define AS_GLOBAL __attribute__((address_space(1)))
#define AS_LDS __attribute__((address_space(3)))
DI void dma16(const void* g, unsigned char* l) { __builtin_amdgcn_global_load_lds((const AS_GLOBAL unsigned*)g, (AS_LDS unsigned*)l, 16, 0, 0); }
template <int NBW>
DI void gemm_mainloop(f32x16 (&acc)[2][NBW], const bf16_t* A, size_t lda, int m0, const bf16_t* Bt, size_t ldb, int n0, int K, unsigned char* lds, bool pre = false, bool only_issue = false) {
    constexpr int STAGE = 65536, BOFF = 32768;
    const int t = opaque_tid(), w = t >> 6, lane = t & 63, r = lane & 31, hh = lane >> 5, wm = w >> 1, wn = w & 1;
    const int drow = w * 8 + (lane >> 3);
    const int lchunk = (lane & 7) ^ ((drow >> 1) & 7);
    const bf16_t* ap = A + (size_t)(m0 + drow) * lda + lchunk * 8;
    const bf16_t* bp = Bt + (size_t)n0 * ldb + lchunk * 8;
    size_t bro[NBW];
#pragma unroll
    for (int j = 0; j < NBW; ++j) {
        const int rho = 64 * j + drow; const int wnh = rho / (32 * NBW), wi = rho % (32 * NBW);
        bro[j] = (size_t)(wnh * 32 * NBW + NBW * (wi & 31) + (wi >> 5)) * ldb;
    }
    unsigned char* ldst = lds + w * 1024 + lane * 16;
#define GEMM_ISSUE(KT, ST) do { const int k1_ = (KT) << 6; unsigned char* d_ = ldst + (ST) * STAGE; \
        _Pragma("unroll") for (int j_ = 0; j_ < 4; ++j_) dma16(ap + (size_t)(64 * j_) * lda + k1_, d_ + j_ * 8192); \
        _Pragma("unroll") for (int j_ = 0; j_ < NBW; ++j_) dma16(bp + bro[j_] + k1_, d_ + BOFF + j_ * 8192); } while (0)
    if (!pre) GEMM_ISSUE(0, 0);
    if (only_issue) return;
    __syncthreads();
    const int nk = K >> 6;
    const int xr = (r >> 1) & 7;
    int xo[4];
#pragma unroll
    for (int s = 0; s < 4; ++s) xo[s] = ((2 * s + hh) ^ xr) << 4;
    const int aofs = (wm * 64 + r) * 128;
    const int bofs = BOFF + (wn * 32 * NBW + r) * 128;
#pragma unroll 1
    for (int kt = 0; kt < nk; ++kt) {
        const unsigned char* st = lds + (kt & 1) * STAGE;
#pragma unroll
        for (int s = 0; s < 4; ++s) {
            if (s == 1 && kt + 1 < nk) GEMM_ISSUE(kt + 1, (kt + 1) & 1);
            bf16x8 a[2], b[NBW];
#pragma unroll
            for (int mb = 0; mb < 2; ++mb) a[mb] = *(const bf16x8*)(st + aofs + mb * 4096 + xo[s]);
#pragma unroll
            for (int nb = 0; nb < NBW; ++nb) b[nb] = *(const bf16x8*)(st + bofs + nb * 4096 + xo[s]);
#pragma unroll
            for (int mb = 0; mb < 2; ++mb)
#pragma unroll
                for (int nb = 0; nb < NBW; ++nb) acc[mb][nb] = MFMA(a[mb], b[nb], acc[mb][nb]);
        }
        __syncthreads();
    }
#undef GEMM_ISSUE
}

DI void epi_p1(const Params& P, f32x16 (&acc)[2][4], int m0, int n0) {
    const int t = opaque_tid(), w = t >> 6, lane = t & 63, r = lane & 31, hh = lane >> 5, wm = w >> 1, wn = w & 1;
    const int seg = (n0 + wn * 128) >> 7;
    unsigned char* ws = P.ws; float* out = P.out;
    const int rbase = m0 + wm * 64 + 4 * hh;
    const int c4 = 4 * r;
    if (seg < 8) {
        const bool isk = seg >= 4; const int head = seg & 3;
        bf16_t* dst = (bf16_t*)(ws + (isk ? WS_RK : WS_RQ)); const float scl = isk ? 0.08838834764831845f : 1.f;
        const float* rope = (const float*)(ws + WS_ROPE);
        const float sgn = (r < 16) ? -1.f : 1.f; const int f4 = 4 * (r & 15);
#pragma unroll
        for (int mb = 0; mb < 2; ++mb)
#pragma unroll
            for (int g = 0; g < 4; ++g) {
                const int rowb = rbase + mb * 32 + 8 * g; int samp, b, p0; decode_row(rowb, samp, b, p0);
                const int ridx0 = samp ? 4224 + p0 : p0;
#pragma unroll
                for (int e = 0; e < 4; ++e) {
                    const int i = 4 * g + e; const size_t row = rowb + e;
                    const f32x4 cs0 = *(const f32x4*)(rope + ((size_t)(ridx0 + e) * 64 + f4) * 2), cs1 = *(const f32x4*)(rope + ((size_t)(ridx0 + e) * 64 + f4) * 2 + 4);
                    const float cc[4] = {cs0.x, cs0.z, cs1.x, cs1.z}, sn[4] = {cs0.y, cs0.w, cs1.y, cs1.w};
                    float o[4];
#pragma unroll
                    for (int nb = 0; nb < 4; ++nb) { const float v = acc[mb][nb][i]; const float pv = __shfl_xor(v, 16); o[nb] = (v * cc[nb] + sgn * pv * sn[nb]) * scl; }
                    u32x2 ov; ov.x = pk2(o[0], o[1]); ov.y = pk2(o[2], o[3]);
                    __builtin_nontemporal_store(ov, (u32x2*)(dst + row * 512 + head * 128 + c4));
                }
            }
    } else if (seg < 24) {
        bf16_t* dst = (bf16_t*)(ws + (seg < 16 ? WS_RV : WS_RG)); const int cb = (seg & 7) * 128 + c4;
#pragma unroll
        for (int mb = 0; mb < 2; ++mb)
#pragma unroll
            for (int i = 0; i < 16; ++i) {
                const size_t row = rbase + mb * 32 + (i & 3) + 8 * (i >> 2);
                u32x2 ov; ov.x = pk2(acc[mb][0][i], acc[mb][1][i]); ov.y = pk2(acc[mb][2][i], acc[mb][3][i]);
                __builtin_nontemporal_store(ov, (u32x2*)(dst + row * 1024 + cb));
            }
    } else if (seg < 40) {
        const bool isk = seg >= 32; const int head = seg & 7;
        const f32x4 gv = *(const f32x4*)((isk ? P.k_norm_g : P.q_norm_g) + c4);
        bf16_t* dst = (bf16_t*)(ws + (isk ? WS_FK : WS_FQ));
#pragma unroll
        for (int mb = 0; mb < 2; ++mb)
#pragma unroll
            for (int g = 0; g < 4; ++g) {
                const int rowb = rbase + mb * 32 + 8 * g; int samp, b, p0; decode_row(rowb, samp, b, p0);
#pragma unroll
                for (int e = 0; e < 4; ++e) {
                    const int i = 4 * g + e; const size_t row = rowb + e; const int p = p0 + e;
                    float ss = 0.f;
#pragma unroll
                    for (int nb = 0; nb < 4; ++nb) ss += acc[mb][nb][i] * acc[mb][nb][i];
                    ss = half_sum32(ss);
                    const float rstd = frsq(ss * (1.f / 128.f) + EPS);
                    f32x4 y; y.x = acc[mb][0][i] * rstd * gv.x; y.y = acc[mb][1][i] * rstd * gv.y; y.z = acc[mb][2][i] * rstd * gv.z; y.w = acc[mb][3][i] * rstd * gv.w;
                    u32x2 ov; ov.x = pk2(y.x, y.y); ov.y = pk2(y.z, y.w);
                    __builtin_nontemporal_store(ov, (u32x2*)(dst + row * 1024 + head * 128 + c4));
                    if (isk) {
                        if (samp) __builtin_nontemporal_store(y, (f32x4*)(out + O_SK + ((size_t)(b * 32 + p) * 8 + head) * 128 + c4));
                        else if (p >= VAL0) __builtin_nontemporal_store(y, (f32x4*)(out + O_PK + (((size_t)b * 8208 + (p - VAL0)) * 8 + head) * 128 + c4));
                    }
                }
            }
    } else if (seg < 48) {
        const int head = seg & 7; bf16_t* VT = (bf16_t*)(ws + WS_VT);
#pragma unroll
        for (int mb = 0; mb < 2; ++mb)
#pragma unroll
            for (int g = 0; g < 4; ++g) {
                const int rowb = rbase + mb * 32 + 8 * g; int samp, b, p0; decode_row(rowb, samp, b, p0);
#pragma unroll
                for (int e = 0; e < 4; ++e) {
                    const int i = 4 * g + e; const int p = p0 + e;
                    f32x4 y; y.x = acc[mb][0][i]; y.y = acc[mb][1][i]; y.z = acc[mb][2][i]; y.w = acc[mb][3][i];
                    if (samp) __builtin_nontemporal_store(y, (f32x4*)(out + O_SV + ((size_t)(b * 32 + p) * 8 + head) * 128 + c4));
                    else if (p >= VAL0) __builtin_nontemporal_store(y, (f32x4*)(out + O_PV + (((size_t)b * 8208 + (p - VAL0)) * 8 + head) * 128 + c4));
                }
                if (!samp) {
#pragma unroll
                    for (int nb = 0; nb < 4; ++nb) {
                        u32x2 o; o.x = pk2(acc[mb][nb][4 * g], acc[mb][nb][4 * g + 1]); o.y = pk2(acc[mb][nb][4 * g + 2], acc[mb][nb][4 * g + 3]);
                        *(u32x2*)(VT + ((size_t)((b * 8 + head) * 128 + c4 + nb)) * LP + p0) = o;
                    }
                }
            }
    } else {
        const bool isb = seg >= 56; const int cb = (seg & 7) * 128 + c4;
        bf16_t* dp = (bf16_t*)out + (isb ? (size_t)33554432 : 0);
        bf16_t* dsm = (bf16_t*)(ws + (isb ? WS_GBS : WS_GAS));
#pragma unroll
        for (int mb = 0; mb < 2; ++mb)
#pragma unroll
            for (int g = 0; g < 4; ++g) {
                const int rowb = rbase + mb * 32 + 8 * g; int samp, b, p0; decode_row(rowb, samp, b, p0);
#pragma unroll
                for (int e = 0; e < 4; ++e) {
                    const int i = 4 * g + e; const int p = p0 + e;
                    bf16_t* d = nullptr;
                    if (samp) d = dsm + (size_t)(b * 32 + p) * 1024; else if (p >= OFF) d = dp + ((size_t)b * 8192 + (p - OFF)) * 1024;
                    if (d) {
                        float s[4];
#pragma unroll
                        for (int nb = 0; nb < 4; ++nb) s[nb] = frcp(1.f + ex2(-LOG2E * acc[mb][nb][i]));
                        u32x2 ov; ov.x = pk2(s[0], s[1]); ov.y = pk2(s[2], s[3]);
                        __builtin_nontemporal_store(ov, (u32x2*)(d + cb));
                    }
                }
            }
    }
}

DI void phase_p1(const Params& P, unsigned char* lds) {
    const bf16_t* A = (const bf16_t*)(P.ws + WS_XN); const bf16_t* Bt = (const bf16_t*)(P.ws + WS_WIN);
    constexpr int NTN = 32;
    bool pre = false;
#pragma unroll 1
    for (int tile = blockIdx.x; tile < NTM * NTN; tile += gridDim.x) {
        const int mt = tile / NTN, nt = tile % NTN;
        f32x16 acc[2][4];
#pragma unroll
        for (int a = 0; a < 2; ++a)
#pragma unroll
            for (int b = 0; b < 4; ++b) acc[a][b] = zero16();
        gemm_mainloop<4>(acc, A, 1024, mt * 256, Bt, 1024, nt * 256, 1024, lds, pre);
        { const int tn = tile + gridDim.x; pre = tn < NTM * NTN; if (pre) { const int mtn = tn / NTN, ntn_ = tn % NTN; f32x16 (&dummy)[2][4] = acc; gemm_mainloop<4>(dummy, A, 1024, mtn * 256, Bt, 1024, ntn_ * 256, 1024, lds, false, true); } }
        epi_p1(P, acc, mt * 256, nt * 256);
    }
}

DI void small_tile(const bf16_t* A, size_t lda, int a0, const bf16_t* Bt, size_t ldb, int b0, int K, float* ctile, float* red) {
    const int t = opaque_tid(), w = t >> 6, lane = t & 63, r = lane & 31, hh = lane >> 5;
    const int kper = K >> 3;
    const bf16_t* ap = A + (size_t)(a0 + r) * lda + w * kper + 8 * hh;
    const bf16_t* bp = Bt + (size_t)(b0 + r) * ldb + w * kper + 8 * hh;
    f32x16 acc = zero16();
#pragma unroll 4
    for (int k = 0; k < kper; k += 16) acc = MFMA(*(const bf16x8*)(ap + k), *(const bf16x8*)(bp + k), acc);
#pragma unroll
    for (int i = 0; i < 16; ++i) red[w * 1024 + i * 64 + lane] = acc[i];
    __syncthreads();
#pragma unroll
    for (int q = 0; q < 2; ++q) {
        const int e = t + 512 * q; float s = 0.f;
#pragma unroll
        for (int ww = 0; ww < 8; ++ww) s += red[ww * 1024 + e];
        const int i = e >> 6, ln = e & 63;
        ctile[crow(i, ln >> 5) * 33 + (ln & 31)] = s;
    }
    __syncthreads();
}

DI void phase_p4(const Params& P, unsigned char* lds) {
    const bf16_t* RO = (const bf16_t*)(P.ws + WS_RG); const bf16_t* FO = (const bf16_t*)(P.ws + WS_FQ);
    const bf16_t* W1 = (const bf16_t*)(P.ws + WS_WRET); const bf16_t* W2 = (const bf16_t*)(P.ws + WS_WFOX);
    bf16_t* M = (bf16_t*)(P.ws + WS_M);
    const bf16_t* GAp = (const bf16_t*)P.out; const bf16_t* GBp = GAp + (size_t)33554432;
    const bf16_t* GAs = (const bf16_t*)(P.ws + WS_GAS); const bf16_t* GBs = (const bf16_t*)(P.ws + WS_GBS);
    const int t = opaque_tid(), w = t >> 6, lane = t & 63, r = lane & 31, hh = lane >> 5, wm = w >> 1, wn = w & 1;
    constexpr int NTN = 8;
    bool pre = false;
#pragma unroll 1
    for (int tile = blockIdx.x; tile < 128 * NTN; tile += gridDim.x) {
        const int mt = tile / NTN, nt = tile % NTN; const int m0 = (mt >> 5) * LP + OFF + (mt & 31) * 256, n0 = nt * 128;
        f32x16 a1[2][2], a2[2][2];
#pragma unroll
        for (int a = 0; a < 2; ++a)
#pragma unroll
            for (int b = 0; b < 2; ++b) { a1[a][b] = zero16(); a2[a][b] = zero16(); }
        gemm_mainloop<2>(a1, RO, 1024, m0, W1, 1024, n0, 1024, lds, pre);
        gemm_mainloop<2>(a2, FO, 1024, m0, W2, 1024, n0, 1024, lds);
        { const int tn = tile + gridDim.x; pre = tn < 128 * NTN; if (pre) { const int mtn = tn / NTN, ntn_ = tn % NTN; gemm_mainloop<2>(a1, RO, 1024, (mtn >> 5) * LP + OFF + (mtn & 31) * 256, W1, 1024, ntn_ * 128, 1024, lds, false, true); } }
        const int col = n0 + wn * 64 + 2 * r;
        const size_t crow0 = (size_t)mt * 256 + wm * 64 + 4 * hh;
#pragma unroll
        for (int mb = 0; mb < 2; ++mb) {
            unsigned ua[16], ub[16];
#pragma unroll
            for (int i = 0; i < 16; ++i) {
                const size_t ci = (crow0 + mb * 32 + (i & 3) + 8 * (i >> 2)) * 1024 + col;
                ua[i] = *(const unsigned*)(GAp + ci); ub[i] = *(const unsigned*)(GBp + ci);
            }
#pragma unroll
            for (int i = 0; i < 16; ++i) {
                const size_t row = (size_t)m0 + wm * 64 + mb * 32 + crow(i, hh);
                const float m0v = bflo(ua[i]) * a1[mb][0][i] + bflo(ub[i]) * a2[mb][0][i];
                const float m1v = bfhi(ua[i]) * a1[mb][1][i] + bfhi(ub[i]) * a2[mb][1][i];
                __builtin_nontemporal_store(pk2(m0v, m1v), (unsigned*)(M + row * 1024 + col));
            }
        }
    }
    {
        float* red = (float*)lds; float* c1 = (float*)(lds + 32768); float* c2 = (float*)(lds + 32768 + 4352);
#pragma unroll 1
        for (int pc = blockIdx.x; pc < 8 * 32; pc += gridDim.x) {
            const int rg = pc >> 5, cg = pc & 31;
            small_tile(RO, 1024, MPR + 32 * rg, W1, 1024, 32 * cg, 1024, c1, red);
            small_tile(FO, 1024, MPR + 32 * rg, W2, 1024, 32 * cg, 1024, c2, red);
            const int rl = t >> 4, cl = (t & 15) * 2; const int srow = 32 * rg + rl, col = 32 * cg + cl;
            const unsigned ua = *(const unsigned*)(GAs + (size_t)srow * 1024 + col), ub = *(const unsigned*)(GBs + (size_t)srow * 1024 + col);
            const float m0v = bflo(ua) * c1[rl * 33 + cl] + bflo(ub) * c2[rl * 33 + cl];
            const float m1v = bfhi(ua) * c1[rl * 33 + cl + 1] + bfhi(ub) * c2[rl * 33 + cl + 1];
            __builtin_nontemporal_store(pk2(m0v, m1v), (unsigned*)(M + (size_t)(MPR + srow) * 1024 + col));
            __syncthreads();
        }
    }
}

DI void phase_p5(const Params& P, unsigned char* lds) {
    const bf16_t* M = (const bf16_t*)(P.ws + WS_M); const bf16_t* W = (const bf16_t*)(P.ws + WS_WO);
    bf16_t* A2 = (bf16_t*)(P.ws + WS_A2); float* SSQ = (float*)(P.ws + WS_SSQ);
    const int t = opaque_tid(), w = t >> 6, lane = t & 63, r = lane & 31, hh = lane >> 5, wm = w >> 1, wn = w & 1;
    constexpr int NTN = 4;
    bool pre = false;
#pragma unroll 1
    for (int tile = blockIdx.x; tile < 128 * NTN; tile += gridDim.x) {
        const int mt = tile / NTN, nt = tile % NTN; const int m0 = (mt >> 5) * LP + OFF + (mt & 31) * 256, n0 = nt * 256;
        f32x16 acc[2][4];
#pragma unroll
        for (int a = 0; a < 2; ++a)
#pragma unroll
            for (int b = 0; b < 4; ++b) acc[a][b] = zero16();
        gemm_mainloop<4>(acc, M, 1024, m0, W, 1024, n0, 1024, lds, pre);
        { const int tn = tile + gridDim.x; pre = tn < 128 * NTN; if (pre) { const int mtn = tn / NTN, ntn_ = tn % NTN; f32x16 (&dummy)[2][4] = acc; gemm_mainloop<4>(dummy, M, 1024, (mtn >> 5) * LP + OFF + (mtn & 31) * 256, W, 1024, ntn_ * 256, 1024, lds, false, true); } }
        const int col = n0 + wn * 128 + 4 * r;
        const f32x4 g2 = *(const f32x4*)(P.norm2_g + col);
        const size_t crow0 = (size_t)mt * 256 + wm * 64 + 4 * hh;
#pragma unroll
        for (int mb = 0; mb < 2; ++mb) {
#pragma unroll
          for (int hf = 0; hf < 2; ++hf) {
            f32x4 xv[16];
#pragma unroll
            for (int i = 8 * hf; i < 8 * hf + 8; ++i) xv[i] = *(const f32x4*)(P.x_prompt + (crow0 + mb * 32 + (i & 3) + 8 * (i >> 2)) * 1024 + col);
#pragma unroll
            for (int i = 8 * hf; i < 8 * hf + 8; ++i) {
                const size_t lr = mb * 32 + (i & 3) + 8 * (i >> 2); const size_t row = (size_t)m0 + wm * 64 + 4 * hh + lr;
                f32x4 h2; h2.x = xv[i].x + acc[mb][0][i]; h2.y = xv[i].y + acc[mb][1][i]; h2.z = xv[i].z + acc[mb][2][i]; h2.w = xv[i].w + acc[mb][3][i];
                __builtin_nontemporal_store(h2, (f32x4*)(P.out + O_Y + (crow0 + lr) * 1024 + col));
                u32x2 ov; ov.x = pk2(h2.x * g2.x, h2.y * g2.y); ov.y = pk2(h2.z * g2.z, h2.w * g2.w);
                __builtin_nontemporal_store(ov, (u32x2*)(A2 + row * 1024 + col));
                float ss = (h2.x * h2.x + h2.y * h2.y) + (h2.z * h2.z + h2.w * h2.w);
                ss = half_sum32(ss);
                if (r == 0) SSQ[row * 8 + nt * 2 + wn] = ss;
            }
          }
        }
    }
    {
        float* red = (float*)lds; float* c1 = (float*)(lds + 32768); float* SSQS = (float*)(P.ws + WS_SSQS);
#pragma unroll 1
        for (int pc = blockIdx.x; pc < 8 * 32; pc += gridDim.x) {
            const int rg = pc >> 5, cg = pc & 31;
            small_tile(M, 1024, MPR + 32 * rg, W, 1024, 32 * cg, 1024, c1, red);
            const int rl = t >> 4, cl = (t & 15) * 2; const int srow = 32 * rg + rl, col = 32 * cg + cl;
            const f32x2 xv = *(const f32x2*)(P.x_sample + (size_t)srow * 1024 + col);
            f32x2 h2; h2.x = xv.x + c1[rl * 33 + cl]; h2.y = xv.y + c1[rl * 33 + cl + 1];
            __builtin_nontemporal_store(h2, (f32x2*)(P.out + O_YS + (size_t)srow * 1024 + col));
            const f32x2 g2 = *(const f32x2*)(P.norm2_g + col);
            __builtin_nontemporal_store(pk2(h2.x * g2.x, h2.y * g2.y), (unsigned*)(A2 + (size_t)(MPR + srow) * 1024 + col));
            float ss = h2.x * h2.x + h2.y * h2.y;
#pragma unroll
            for (int o = 1; o < 16; o <<= 1) ss += __shfl_xor(ss, o);
            if ((t & 15) == 0) SSQS[srow * 32 + cg] = ss;
            __syncthreads();
        }
    }
}

DI void phase_p6(const Params& P, unsigned char* lds) {
    const bf16_t* A2 = (const bf16_t*)(P.ws + WS_A2); const bf16_t* W = (const bf16_t*)(P.ws + WS_WFF1);
    bf16_t* U = (bf16_t*)(P.ws + WS_U); const float* SSQ = (const float*)(P.ws + WS_SSQ);
    const int t = opaque_tid(), w = t >> 6, lane = t & 63, r = lane & 31, hh = lane >> 5, wm = w >> 1, wn = w & 1;
    constexpr int NTN = 16;
    bool pre = false; int rtpar = 0;
#pragma unroll 1
    for (int tile = blockIdx.x; tile < 128 * NTN; tile += gridDim.x) {
        const int mt = tile / NTN, nt = tile % NTN; const int m0 = (mt >> 5) * LP + OFF + (mt & 31) * 256, n0 = nt * 256;
        f32x16 acc[2][4];
#pragma unroll
        for (int a = 0; a < 2; ++a)
#pragma unroll
            for (int b = 0; b < 4; ++b) acc[a][b] = zero16();
        {
            float* rt = (float*)(lds + 131072 + (rtpar & 1) * 1024);
            if (t < 256) {
                const size_t row = (size_t)m0 + t;
                const f32x4 s0 = *(const f32x4*)(SSQ + row * 8), s1 = *(const f32x4*)(SSQ + row * 8 + 4);
                const float ss = ((s0.x + s0.y) + (s0.z + s0.w)) + ((s1.x + s1.y) + (s1.z + s1.w));
                rt[t] = frsq(ss * (1.f / 1024.f) + EPS);
            }
        }
        gemm_mainloop<4>(acc, A2, 1024, m0, W, 1024, n0, 1024, lds, pre);
        { const int tn = tile + gridDim.x; pre = tn < 128 * NTN; if (pre) { const int mtn = tn / NTN, ntn_ = tn % NTN; f32x16 (&dummy)[2][4] = acc; gemm_mainloop<4>(dummy, A2, 1024, (mtn >> 5) * LP + OFF + (mtn & 31) * 256, W, 1024, ntn_ * 256, 1024, lds, false, true); } }
        const int col = n0 + wn * 128 + 4 * r;
#pragma unroll
        for (int mb = 0; mb < 2; ++mb)
#pragma unroll
            for (int i = 0; i < 16; ++i) {
                const size_t row = m0 + wm * 64 + mb * 32 + crow(i, hh);
                const float rstd = ((const float*)(lds + 131072 + (rtpar & 1) * 1024))[wm * 64 + mb * 32 + crow(i, hh)];
                float u[4];
#pragma unroll
                for (int nb = 0; nb < 4; ++nb) { const float v = fmaxf(acc[mb][nb][i] * rstd, 0.f); u[nb] = v * v; }
                u32x2 ov; ov.x = pk2(u[0], u[1]); ov.y = pk2(u[2], u[3]);
                __builtin_nontemporal_store(ov, (u32x2*)(U + row * 4096 + col));
            }
        ++rtpar;
    }
    {
        float* red = (float*)lds; float* c1 = (float*)(lds + 32768); const float* SSQS = (const float*)(P.ws + WS_SSQS);
#pragma unroll 1
        for (int pc = blockIdx.x; pc < 8 * 128; pc += gridDim.x) {
            const int rg = pc >> 7, cg = pc & 127;
            small_tile(A2, 1024, MPR + 32 * rg, W, 1024, 32 * cg, 1024, c1, red);
            const int rl = t >> 4, cl = (t & 15) * 2; const int srow = 32 * rg + rl, col = 32 * cg + cl;
            float ss = 0.f;
#pragma unroll
            for (int j = 0; j < 8; ++j) { const f32x4 sv = *(const f32x4*)(SSQS + srow * 32 + 4 * j); ss += (sv.x + sv.y) + (sv.z + sv.w); }
            const float rstd = frsq(ss * (1.f / 1024.f) + EPS);
            const float u0 = fmaxf(c1[rl * 33 + cl] * rstd, 0.f), u1 = fmaxf(c1[rl * 33 + cl + 1] * rstd, 0.f);
            __builtin_nontemporal_store(pk2(u0 * u0, u1 * u1), (unsigned*)(U + (size_t)(MPR + srow) * 4096 + col));
            __syncthreads();
        }
    }
}

DI void phase_p7(const Params& P, unsigned char* lds) {
    const bf16_t* U = (const bf16_t*)(P.ws + WS_U); const bf16_t* W = (const bf16_t*)(P.ws + WS_WFF2);
    const int t = opaque_tid(), w = t >> 6, lane = t & 63, r = lane & 31, hh = lane >> 5, wm = w >> 1, wn = w & 1;
    constexpr int NTN = 4;
    bool pre = false;
#pragma unroll 1
    for (int tile = blockIdx.x; tile < 128 * NTN; tile += gridDim.x) {
        const int mt = tile / NTN, nt = tile % NTN; const int m0 = (mt >> 5) * LP + OFF + (mt & 31) * 256, n0 = nt * 256;
        f32x16 acc[2][4];
#pragma unroll
        for (int a = 0; a < 2; ++a)
#pragma unroll
            for (int b = 0; b < 4; ++b) acc[a][b] = zero16();
        gemm_mainloop<4>(acc, U, 4096, m0, W, 4096, n0, 4096, lds, pre);
        { const int tn = tile + gridDim.x; pre = tn < 128 * NTN; if (pre) { const int mtn = tn / NTN, ntn_ = tn % NTN; f32x16 (&dummy)[2][4] = acc; gemm_mainloop<4>(dummy, U, 4096, (mtn >> 5) * LP + OFF + (mtn & 31) * 256, W, 4096, ntn_ * 256, 4096, lds, false, true); } }
        const int col = n0 + wn * 128 + 4 * r;
        const size_t crow0 = (size_t)mt * 256 + wm * 64 + 4 * hh;
#pragma unroll
        for (int mb = 0; mb < 2; ++mb) {
#pragma unroll
          for (int hf = 0; hf < 2; ++hf) {
            f32x4 yv[16];
#pragma unroll
            for (int i = 8 * hf; i < 8 * hf + 8; ++i) yv[i] = *(const f32x4*)(P.out + O_Y + (crow0 + mb * 32 + (i & 3) + 8 * (i >> 2)) * 1024 + col);
#pragma unroll
            for (int i = 8 * hf; i < 8 * hf + 8; ++i) {
                f32x4 o = yv[i]; o.x += acc[mb][0][i]; o.y += acc[mb][1][i]; o.z += acc[mb][2][i]; o.w += acc[mb][3][i];
                __builtin_nontemporal_store(o, (f32x4*)(P.out + O_Y + (crow0 + mb * 32 + (i & 3) + 8 * (i >> 2)) * 1024 + col));
            }
          }
        }
    }
    {
        float* red = (float*)lds; float* c1 = (float*)(lds + 32768);
#pragma unroll 1
        for (int pc = blockIdx.x; pc < 8 * 32; pc += gridDim.x) {
            const int rg = pc >> 5, cg = pc & 31;
            small_tile(U, 4096, MPR + 32 * rg, W, 4096, 32 * cg, 4096, c1, red);
            const int rl = t >> 4, cl = (t & 15) * 2; const int srow = 32 * rg + rl, col = 32 * cg + cl;
            f32x2* yp = (f32x2*)(P.out + O_YS + (size_t)srow * 1024 + col);
            f32x2 yv = *yp; yv.x += c1[rl * 33 + cl]; yv.y += c1[rl * 33 + cl + 1]; *yp = yv;
            __syncthreads();
        }
    }
}

template <bool OUT>
DI void ret_chunk(const Params& P, unsigned char* lds, f32x16 (&S)[4], size_t row0, int CL, int head, float lg2_in) {
    float lg2 = lg2_in; asm volatile("" : "+v"(lg2));
    const int t = opaque_tid(), w = t >> 6, lane = t & 63, r = lane & 31, hh = lane >> 5;
    const bf16_t* RQ = (const bf16_t*)(P.ws + WS_RQ); const bf16_t* RK = (const bf16_t*)(P.ws + WS_RK); const bf16_t* RV = (const bf16_t*)(P.ws + WS_RV);
    bf16_t* RG = (bf16_t*)(P.ws + WS_RG);
    unsigned char* Qs = lds; unsigned char* Ks = lds + 17408; unsigned char* KTs = lds + 34816; unsigned char* VTs = lds + 53248; float* OUTs = (float*)(lds + 90112);
    {
        const int n = t & 63; const bool live = n < CL;
        const float kdec = ex2((float)(CL - 1 - n) * lg2);
#pragma unroll
        for (int i = 0; i < 2; ++i) {
            const int dc = (t >> 6) + 8 * i;
            u32x4 kv = (u32x4){0u, 0u, 0u, 0u};
            if (live) kv = *(const u32x4*)(RK + (row0 + n) * 512 + head * 128 + dc * 8);
            if (OUT) {
                u32x4 qv = (u32x4){0u, 0u, 0u, 0u};
                if (live) qv = *(const u32x4*)(RQ + (row0 + n) * 512 + head * 128 + dc * 8);
                *(u32x4*)(Qs + n * 272 + dc * 16) = qv; *(u32x4*)(Ks + n * 272 + dc * 16) = kv;
            }
#pragma unroll
            for (int e = 0; e < 4; ++e) {
                const unsigned u = kv[e];
                *(bf16_t*)(KTs + (dc * 8 + 2 * e) * 144 + n * 2) = f2bf(bflo(u) * kdec);
                *(bf16_t*)(KTs + (dc * 8 + 2 * e + 1) * 144 + n * 2) = f2bf(bfhi(u) * kdec);
            }
        }
#pragma unroll
        for (int i = 0; i < 4; ++i) {
            const int vc = (t >> 6) + 8 * i;
            u32x4 vv = (u32x4){0u, 0u, 0u, 0u};
            if (live) vv = *(const u32x4*)(RV + (row0 + n) * 1024 + head * 256 + vc * 8);
#pragma unroll
            for (int e = 0; e < 4; ++e) {
                const unsigned u = vv[e];
                *(bf16_t*)(VTs + (vc * 8 + 2 * e) * 144 + n * 2) = (bf16_t)(u & 0xffffu);
                *(bf16_t*)(VTs + (vc * 8 + 2 * e + 1) * 144 + n * 2) = (bf16_t)(u >> 16);
            }
        }
    }
    __syncthreads();
    __builtin_amdgcn_sched_barrier(0);
    if (OUT) {
        f32x16 o[2]; o[0] = zero16(); o[1] = zero16();
#pragma unroll
        for (int db = 0; db < 4; ++db)
#pragma unroll
            for (int sp = 0; sp < 2; ++sp) {
                const bf16x8 bs = pack8(S[db], sp);
#pragma unroll
                for (int nbo = 0; nbo < 2; ++nbo) {
                    const unsigned char* qa = Qs + (32 * nbo + r) * 272 + (32 * db + 16 * sp + 4 * hh) * 2;
                    const bf16x8 a = cat4(*(const s16x4*)qa, *(const s16x4*)(qa + 16));
                    o[nbo] = MFMA(a, bs, o[nbo]);
                }
            }
        __builtin_amdgcn_sched_barrier(0);
#pragma unroll
        for (int nbo = 0; nbo < 2; ++nbo)
#pragma unroll
            for (int i = 0; i < 16; ++i) o[nbo][i] *= ex2((float)(32 * nbo + crow(i, hh) + 1) * lg2);
        __builtin_amdgcn_sched_barrier(0);
#pragma unroll
        for (int tix = 0; tix < 3; ++tix) {
            const int mb = (tix == 2) ? 1 : 0, nb = (tix == 0) ? 0 : 1;
            __builtin_amdgcn_sched_barrier(0);
            f32x16 x = zero16();
#pragma unroll
            for (int s = 0; s < 8; ++s) {
                const bf16x8 a = *(const bf16x8*)(Ks + (32 * mb + r) * 272 + (16 * s + 8 * hh) * 2);
                const bf16x8 b = *(const bf16x8*)(Qs + (32 * nb + r) * 272 + (16 * s + 8 * hh) * 2);
                x = MFMA(a, b, x);
            }
#pragma unroll
            for (int i = 0; i < 16; ++i) {
                const int d = (32 * nb + r) - (32 * mb + crow(i, hh));
                x[i] = (d >= 0) ? x[i] * ex2((float)d * lg2) : 0.f;
            }
#pragma unroll
            for (int sp = 0; sp < 2; ++sp) {
                const bf16x8 xa = pack8(x, sp);
                const unsigned char* va = VTs + (32 * w + r) * 144 + (32 * mb + 16 * sp + 4 * hh) * 2;
                const bf16x8 b = cat4(*(const s16x4*)va, *(const s16x4*)(va + 16));
                o[nb] = MFMA(xa, b, o[nb]);
            }
        }
        __builtin_amdgcn_sched_barrier(0);
#pragma unroll
        for (int nb = 0; nb < 2; ++nb)
#pragma unroll
            for (int i = 0; i < 16; ++i) OUTs[(32 * nb + crow(i, hh)) * 260 + 32 * w + r] = o[nb][i];
        __builtin_amdgcn_sched_barrier(0);
    }
    {
        const float gC = ex2((float)CL * lg2);
#pragma unroll
        for (int db = 0; db < 4; ++db) S[db] = S[db] * gC;
#pragma unroll
        for (int s = 0; s < 4; ++s) {
            const bf16x8 b = *(const bf16x8*)(VTs + (32 * w + r) * 144 + (16 * s + 8 * hh) * 2);
#pragma unroll
            for (int db = 0; db < 4; ++db) {
                const bf16x8 a = *(const bf16x8*)(KTs + (32 * db + r) * 144 + (16 * s + 8 * hh) * 2);
                S[db] = MFMA(a, b, S[db]);
            }
        }
    }
    __syncthreads();
    __builtin_amdgcn_sched_barrier(0);
    if (OUT) {
        const int n = t >> 3, sg = t & 7;
        f32x4 xv[8]; float s1 = 0.f, s2 = 0.f;
#pragma unroll
        for (int j = 0; j < 8; ++j) {
            xv[j] = *(const f32x4*)(OUTs + n * 260 + sg * 32 + 4 * j);
            s1 += (xv[j].x + xv[j].y) + (xv[j].z + xv[j].w);
            s2 += (xv[j].x * xv[j].x + xv[j].y * xv[j].y) + (xv[j].z * xv[j].z + xv[j].w * xv[j].w);
        }
#pragma unroll
        for (int o = 1; o < 8; o <<= 1) { s1 += __shfl_xor(s1, o); s2 += __shfl_xor(s2, o); }
        const float mean = s1 * (1.f / 256.f); const float var = fmaxf(s2 * (1.f / 256.f) - mean * mean, 0.f);
        const float rstd = frsq(var + EPS);
        if (n < CL) {
            bf16_t* gp = RG + (row0 + n) * 1024 + head * 256 + sg * 32;
            const float* gn = P.ret_gn_g + head * 256 + sg * 32;
            u32x4 gu[4];
#pragma unroll
            for (int j = 0; j < 4; ++j) gu[j] = *(const u32x4*)(gp + 8 * j);
#pragma unroll
            for (int j = 0; j < 4; ++j) {
                const f32x4 g0 = *(const f32x4*)(gn + 8 * j), g1 = *(const f32x4*)(gn + 8 * j + 4);
                const f32x4 xa = xv[2 * j], xb = xv[2 * j + 1];
                float y[8], gt[8];
                gt[0] = bflo(gu[j].x); gt[1] = bfhi(gu[j].x); gt[2] = bflo(gu[j].y); gt[3] = bfhi(gu[j].y); gt[4] = bflo(gu[j].z); gt[5] = bfhi(gu[j].z); gt[6] = bflo(gu[j].w); gt[7] = bfhi(gu[j].w);
                y[0] = (xa.x - mean) * rstd * g0.x; y[1] = (xa.y - mean) * rstd * g0.y; y[2] = (xa.z - mean) * rstd * g0.z; y[3] = (xa.w - mean) * rstd * g0.w;
                y[4] = (xb.x - mean) * rstd * g1.x; y[5] = (xb.y - mean) * rstd * g1.y; y[6] = (xb.z - mean) * rstd * g1.z; y[7] = (xb.w - mean) * rstd * g1.w;
#pragma unroll
                for (int e = 0; e < 8; ++e) y[e] *= gt[e] * frcp(1.f + ex2(-LOG2E * gt[e]));
                u32x4 ou; ou.x = pk2(y[0], y[1]); ou.y = pk2(y[2], y[3]); ou.z = pk2(y[4], y[5]); ou.w = pk2(y[6], y[7]);
                *(u32x4*)(gp + 8 * j) = ou;
            }
        }
    }
}

DI float head_lg2(int head) { return log2f(1.f - 1.f / (float)(32 << head)); }

DI void ret_passA_item(const Params& P, unsigned char* lds, int item) {
    const int bh = item / 12, g = item % 12, b = bh >> 2, head = bh & 3;
    const int t = opaque_tid(), w = t >> 6, lane = t & 63;
    const float lg2 = head_lg2(head);
    f32x16 S[4];
#pragma unroll
    for (int db = 0; db < 4; ++db) S[db] = zero16();
#pragma unroll 1
    for (int c = 0; c < 10; ++c) ret_chunk<false>(P, lds, S, (size_t)b * LP + 640 * g + 64 * c, 64, head, lg2);
    float* T = (float*)(P.ws + WS_TG) + ((size_t)item * 8 + w) * 4096;
#pragma unroll
    for (int db = 0; db < 4; ++db)
#pragma unroll
        for (int i = 0; i < 16; ++i) T[(db * 16 + i) * 64 + lane] = S[db][i];
}

DI void ret_passC_prompt(const Params& P, unsigned char* lds, int bh, int g) {
    const int b = bh >> 2, head = bh & 3;
    const int t = opaque_tid(), w = t >> 6, lane = t & 63, r = lane & 31, hh = lane >> 5;
    const float lg2 = head_lg2(head);
    f32x16 S[4];
#pragma unroll
    for (int db = 0; db < 4; ++db) S[db] = zero16();
    const float g640 = ex2(640.f * lg2);
#pragma unroll 1
    for (int gp = 0; gp < g; ++gp) {
        const float* T = (const float*)(P.ws + WS_TG) + ((size_t)(bh * 12 + gp) * 8 + w) * 4096;
#pragma unroll
        for (int db = 0; db < 4; ++db)
#pragma unroll
            for (int i = 0; i < 16; ++i) S[db][i] = S[db][i] * g640 + T[(db * 16 + i) * 64 + lane];
    }
#pragma unroll 1
    for (int c = 0; c < 10; ++c) ret_chunk<true>(P, lds, S, (size_t)b * LP + 640 * g + 64 * c, 64, head, lg2);
    if (g == 12) {
        float* dst = P.out + O_PST + (size_t)bh * 32768;
#pragma unroll
        for (int db = 0; db < 4; ++db)
#pragma unroll
            for (int i = 0; i < 16; ++i) dst[(32 * db + crow(i, hh)) * 256 + 32 * w + r] = S[db][i];
    }
    __syncthreads();
}

DI void ret_sample_item(const Params& P, unsigned char* lds, int sb, int head) {
    const int t = opaque_tid(), w = t >> 6, lane = t & 63, r = lane & 31, hh = lane >> 5;
    const float lg2 = head_lg2(head);
    const float* src = P.state_ret + (size_t)(sb * 4 + head) * 32768;
    f32x16 S[4];
#pragma unroll
    for (int db = 0; db < 4; ++db)
#pragma unroll
        for (int i = 0; i < 16; ++i) S[db][i] = src[(32 * db + crow(i, hh)) * 256 + 32 * w + r];
    ret_chunk<true>(P, lds, S, (size_t)MPR + sb * 32, 32, head, lg2);
    float* dst = P.out + O_SST + (size_t)(sb * 4 + head) * 32768;
#pragma unroll
    for (int db = 0; db < 4; ++db)
#pragma unroll
        for (int i = 0; i < 16; ++i) dst[(32 * db + crow(i, hh)) * 256 + 32 * w + r] = S[db][i];
    __syncthreads();
}

DI double wave_incl_scan(double v, int lane) {
#pragma unroll
    for (int o = 1; o < 64; o <<= 1) { const double u = __shfl_up(v, o); if (lane >= o) v += u; }
    return v;
}
DI void cumsum_seq(const Params& P, int seq, int lane) {
    if (seq < 32) {
        const int b = seq >> 3, h = seq & 7;
        const float* lf = (const float*)(P.ws + WS_LOGF) + (size_t)b * LP * 8 + h;
        float* nck = (float*)(P.ws + WS_NCKP) + (size_t)seq * LP;
        double loc = 0.0;
#pragma unroll 1
        for (int bt = 0; bt < 5; ++bt) {
            float v[26];
#pragma unroll
            for (int j = 0; j < 26; ++j) v[j] = lf[(size_t)(130 * lane + 26 * bt + j) * 8];
#pragma unroll
            for (int j = 0; j < 26; ++j) loc += (double)v[j];
        }
        const double inc = wave_incl_scan(loc, lane);
        double run = inc - loc;
#pragma unroll 1
        for (int bt = 0; bt < 5; ++bt) {
            float v[26];
#pragma unroll
            for (int j = 0; j < 26; ++j) v[j] = lf[(size_t)(130 * lane + 26 * bt + j) * 8];
#pragma unroll
            for (int j = 0; j < 26; ++j) { const int p = 130 * lane + 26 * bt + j; run += (double)v[j]; nck[p] = (p < VAL0) ? -1e30f : -(float)run; }
        }
    } else {
        const int s = seq - 32, sb = s >> 3, h = s & 7;
        const float* cl = P.cache_logf + (size_t)sb * 4096 * 8 + h;
        float* nck = (float*)(P.ws + WS_NCKS) + (size_t)s * 4128;
        double loc = 0.0;
#pragma unroll 1
        for (int bt = 0; bt < 4; ++bt) {
            float v[16];
#pragma unroll
            for (int j = 0; j < 16; ++j) v[j] = cl[(size_t)(64 * lane + 16 * bt + j) * 8];
#pragma unroll
            for (int j = 0; j < 16; ++j) loc += (double)v[j];
        }
        const double inc = wave_incl_scan(loc, lane);
        double run = inc - loc;
#pragma unroll 1
        for (int bt = 0; bt < 4; ++bt) {
            float v[16];
#pragma unroll
            for (int j = 0; j < 16; ++j) v[j] = cl[(size_t)(64 * lane + 16 * bt + j) * 8];
#pragma unroll
            for (int j = 0; j < 16; ++j) { const int p = 64 * lane + 16 * bt + j; run += (double)v[j]; nck[p] = -(float)run; }
        }
        const double tot = __shfl(inc, 63);
        const float* lf = (const float*)(P.ws + WS_LOGF) + ((size_t)MPR + sb * 32) * 8 + h;
        const double mine = (lane < 32) ? (double)lf[(size_t)lane * 8] : 0.0;
        const double inc2 = wave_incl_scan(mine, lane);
        if (lane < 32) nck[4096 + lane] = -(float)(tot + inc2);
    }
}

DI void phase_p2(const Params& P, unsigned char* lds) {
    constexpr int NRET = 192, NCUM = 12;
    for (int it = blockIdx.x; it < NRET + NCUM; it += gridDim.x) {
        if (it < NRET) { ret_passA_item(P, lds, it); __syncthreads(); }
        else { const int seq = (it - NRET) * 8 + (threadIdx.x >> 6); cumsum_seq(P, seq, threadIdx.x & 63); }
    }
}

DI void attn_prompt_item(const Params& P, unsigned char* lds, int b, int head, int qb, float qkb2) {
    const int t = opaque_tid(), w = t >> 6, lane = t & 63, r = lane & 31, hh = lane >> 5;
    const bf16_t* FK = (const bf16_t*)(P.ws + WS_FK); const bf16_t* VT = (const bf16_t*)(P.ws + WS_VT); bf16_t* FQ = (bf16_t*)(P.ws + WS_FQ);
    const float* NCK = (const float*)(P.ws + WS_NCKP) + (size_t)(b * 8 + head) * LP;
    const int q0 = OFF + 256 * qb, qw0 = q0 + 32 * w, myq = qw0 + r;
    const float cref = -NCK[q0];
    bf16_t* qp = FQ + ((size_t)b * LP + myq) * 1024 + head * 128;
    bf16x8 qf[8];
#pragma unroll
    for (int s = 0; s < 8; ++s) qf[s] = *(const bf16x8*)(qp + 16 * s + 8 * hh);
    f32x16 o[4];
#pragma unroll
    for (int db = 0; db < 4; ++db) o[db] = zero16();
    float m_run = -1e30f, l_run = 0.f;
    const int kt_last = (q0 + 255) >> 6;
    constexpr int BUF = 36864, VOFF = 17408, BOFF = 35840, WMOFF = 3 * BUF;
    const int kkey = t >> 4, kdc = t & 15;
    const int vd = t >> 3, vkc = t & 7;
    const bf16_t* kg = FK + ((size_t)b * LP + kkey) * 1024 + head * 128 + kdc * 8;
    const bf16_t* vg = VT + ((size_t)((b * 8 + head) * 128 + vd)) * LP + vkc * 8;
    u32x4 kr[2], vr[2]; float br = 0.f;
#define ATT_GLOAD(KT) do { const int kbase_ = (KT) * 64; \
        kr[0] = *(const u32x4*)(kg + (size_t)kbase_ * 1024); kr[1] = *(const u32x4*)(kg + (size_t)(kbase_ + 32) * 1024); \
        vr[0] = *(const u32x4*)(vg + kbase_); vr[1] = *(const u32x4*)(vg + (size_t)64 * LP + kbase_); \
        if (t < 64) br = (NCK[kbase_ + t] + cref) * LOG2E; } while (0)
#define ATT_SWRITE(BI) do { unsigned char* sb_ = lds + (BI) * BUF; \
        *(u32x4*)(sb_ + kkey * 272 + kdc * 16) = kr[0]; *(u32x4*)(sb_ + (kkey + 32) * 272 + kdc * 16) = kr[1]; \
        *(u32x4*)(sb_ + VOFF + vd * 144 + vkc * 16) = vr[0]; *(u32x4*)(sb_ + VOFF + (vd + 64) * 144 + vkc * 16) = vr[1]; \
        if (t < 64) *(float*)(sb_ + BOFF + t * 4) = br; } while (0)
#define ATT_PV(SBV, PP) do { _Pragma("unroll") for (int kb_ = 0; kb_ < 2; ++kb_) _Pragma("unroll") for (int sp_ = 0; sp_ < 2; ++sp_) _Pragma("unroll") for (int db_ = 0; db_ < 4; ++db_) { \
        const unsigned char* va_ = (SBV) + VOFF + (32 * db_ + r) * 144 + (32 * kb_ + 16 * sp_ + 4 * hh) * 2; \
        o[db_] = MFMA(cat4(*(const s16x4*)va_, *(const s16x4*)(va_ + 16)), PP[kb_][sp_], o[db_]); } } while (0)
    float* WM = (float*)(lds + WMOFF);
    if (t < 16) WM[t] = -1e30f;
    ATT_GLOAD(kt_last); ATT_SWRITE(kt_last % 3);
    __syncthreads();
    const bool late = __builtin_amdgcn_readfirstlane(w) >= 4;
    bf16x8 pp[2][2]; bool pending = false; int pbuf = 0;
#pragma unroll 1
    for (int kt = kt_last; kt >= 1; --kt) {
        const int bi = kt % 3;
        const unsigned char* sb = lds + bi * BUF;
        {
            const f32x4 w0 = *(const f32x4*)(WM + ((kt + 1) & 1) * 8), w1 = *(const f32x4*)(WM + ((kt + 1) & 1) * 8 + 4);
            const float mfloor = fminf(fminf(fminf(w0.x, w0.y), fminf(w0.z, w0.w)), fminf(fminf(w1.x, w1.y), fminf(w1.z, w1.w)));
            const float blast = *(const float*)(sb + BOFF + 63 * 4);
            if (blast + qkb2 < mfloor - 32.f) break;
        }
        const bool more = kt > 1;
        if (more) ATT_GLOAD(kt - 1);
        if (pending) { ATT_PV(lds + pbuf * BUF, pp); pending = false; }
        float wmin = -1e30f;
        if (kt * 64 <= qw0 + 31) {
            f32x16 st[2];
#pragma unroll
            for (int kb = 0; kb < 2; ++kb) {
                st[kb] = zero16();
#pragma unroll
                for (int s = 0; s < 8; ++s) {
                    const bf16x8 a = *(const bf16x8*)(sb + (32 * kb + r) * 272 + (16 * s + 8 * hh) * 2);
                    st[kb] = MFMA(a, qf[s], st[kb]);
                }
            }
            const bool need_mask = (kt * 64 + 63 > qw0);
            float mx = -1e30f;
#pragma unroll
            for (int kb = 0; kb < 2; ++kb)
#pragma unroll
                for (int g = 0; g < 4; ++g) {
                    const f32x4 bz = *(const f32x4*)(sb + BOFF + (32 * kb + 8 * g + 4 * hh) * 4);
#pragma unroll
                    for (int e = 0; e < 4; ++e) {
                        float v = st[kb][4 * g + e] * ATT_SC + bz[e];
                        if (need_mask) { const int key = kt * 64 + 32 * kb + 8 * g + 4 * hh + e; v = (key > myq) ? -1e30f : v; }
                        st[kb][4 * g + e] = v; mx = fmaxf(mx, v);
                    }
                }
            mx = fmaxf(mx, __shfl_xor(mx, 32));
            const float m_new = fmaxf(m_run, mx);
            const bool grew = __builtin_amdgcn_ballot_w64(m_new > m_run) != 0ull;
            float ps = 0.f;
#pragma unroll
            for (int kb = 0; kb < 2; ++kb)
#pragma unroll
                for (int i = 0; i < 16; ++i) { const float pv = ex2(st[kb][i] - m_new); st[kb][i] = pv; ps += pv; }
            if (grew) {
                const float alpha = ex2(m_run - m_new); m_run = m_new;
                l_run = l_run * alpha;
#pragma unroll
                for (int db = 0; db < 4; ++db) o[db] = o[db] * alpha;
            }
            l_run += ps;
#pragma unroll
            for (int kb = 0; kb < 2; ++kb)
#pragma unroll
                for (int sp = 0; sp < 2; ++sp) pp[kb][sp] = pack8(st[kb], sp);
            if (late) { pending = true; pbuf = bi; }
            else ATT_PV(sb, pp);
            wmin = m_run;
#pragma unroll
            for (int of = 1; of < 32; of <<= 1) wmin = fminf(wmin, __shfl_xor(wmin, of));
        }
        if (lane == 0) WM[(kt & 1) * 8 + w] = wmin;
        if (more) ATT_SWRITE((kt - 1) % 3);
        __syncthreads();
    }
    if (pending) ATT_PV(lds + pbuf * BUF, pp);
#undef ATT_GLOAD
#undef ATT_SWRITE
#undef ATT_PV
    const float lt = l_run + __shfl_xor(l_run, 32);
    const float inv = frcp(lt);
#pragma unroll
    for (int db = 0; db < 4; ++db)
#pragma unroll
        for (int g = 0; g < 4; ++g) {
            u32x2 ov; ov.x = pk2(o[db][4 * g] * inv, o[db][4 * g + 1] * inv); ov.y = pk2(o[db][4 * g + 2] * inv, o[db][4 * g + 3] * inv);
            *(u32x2*)(qp + 32 * db + 8 * g + 4 * hh) = ov;
        }
}

DI void attn_sample_item(const Params& P, unsigned char* lds, int sb, int head) {
    const int t = opaque_tid(), w = t >> 6, lane = t & 63, r = lane & 31, hh = lane >> 5;
    bf16_t* FQ = (bf16_t*)(P.ws + WS_FQ);
    const float* NCK = (const float*)(P.ws + WS_NCKS) + (size_t)(sb * 8 + head) * 4128;
    const float cref = -NCK[4096];
    bf16_t* qrow = FQ + ((size_t)MPR + sb * 32) * 1024 + head * 128;
    bf16x8 qf[8];
#pragma unroll
    for (int s = 0; s < 8; ++s) qf[s] = *(const bf16x8*)(qrow + (size_t)r * 1024 + 16 * s + 8 * hh);
    f32x16 o[4];
#pragma unroll
    for (int db = 0; db < 4; ++db) o[db] = zero16();
    float m_run = -1e30f, l_run = 0.f;
#pragma unroll 1
    for (int tile = w; tile < 129; tile += 8) {
        const float *kbase, *vbase;
        if (tile < 128) { const size_t off = ((size_t)sb * 4096 + 32 * tile) * 1024 + head * 128; kbase = P.cache_k + off; vbase = P.cache_v + off; }
        else { const size_t off = (size_t)sb * 32 * 1024 + head * 128; kbase = P.out + O_SK + off; vbase = P.out + O_SV + off; }
        f32x16 st = zero16();
#pragma unroll
        for (int s = 0; s < 8; ++s) {
            const float* kp = kbase + (size_t)r * 1024 + 16 * s + 8 * hh;
            const f32x4 k0 = *(const f32x4*)kp, k1 = *(const f32x4*)(kp + 4);
            u32x4 pk; pk.x = pk2(k0.x, k0.y); pk.y = pk2(k0.z, k0.w); pk.z = pk2(k1.x, k1.y); pk.w = pk2(k1.z, k1.w);
            st = MFMA(__builtin_bit_cast(bf16x8, pk), qf[s], st);
        }
        float mx = -1e30f;
#pragma unroll
        for (int g = 0; g < 4; ++g) {
            const f32x4 bz = *(const f32x4*)(NCK + 32 * tile + 8 * g + 4 * hh);
#pragma unroll
            for (int e = 0; e < 4; ++e) {
                float v = st[4 * g + e] * ATT_SC + (bz[e] + cref) * LOG2E;
                if (tile == 128) { const int key = 8 * g + 4 * hh + e; v = (key > r) ? -1e30f : v; }
                st[4 * g + e] = v; mx = fmaxf(mx, v);
            }
        }
        mx = fmaxf(mx, __shfl_xor(mx, 32));
        const float m_new = fmaxf(m_run, mx);
        const float alpha = ex2(m_run - m_new); m_run = m_new;
        float ps = 0.f;
#pragma unroll
        for (int i = 0; i < 16; ++i) { const float pv = ex2(st[i] - m_new); st[i] = pv; ps += pv; }
        l_run = l_run * alpha + ps;
#pragma unroll
        for (int db = 0; db < 4; ++db) o[db] = o[db] * alpha;
#pragma unroll
        for (int sp = 0; sp < 2; ++sp) {
            const bf16x8 pb = pack8(st, sp);
#pragma unroll
            for (int db = 0; db < 4; ++db) {
                const float* vp = vbase + (size_t)(16 * sp + 4 * hh) * 1024 + 32 * db + r;
                float f[8];
#pragma unroll
                for (int j = 0; j < 8; ++j) f[j] = vp[(size_t)((j & 3) + 8 * (j >> 2)) * 1024];
                u32x4 pk; pk.x = pk2(f[0], f[1]); pk.y = pk2(f[2], f[3]); pk.z = pk2(f[4], f[5]); pk.w = pk2(f[6], f[7]);
                o[db] = MFMA(__builtin_bit_cast(bf16x8, pk), pb, o[db]);
            }
        }
    }
    const float lt = l_run + __shfl_xor(l_run, 32);
    float* Ol = (float*)lds; float* ML = (float*)(lds + 131072);
#pragma unroll
    for (int db = 0; db < 4; ++db)
#pragma unroll
        for (int i = 0; i < 16; ++i) Ol[(w * 128 + 32 * db + crow(i, hh)) * 32 + r] = o[db][i];
    if (hh == 0) { ML[(w * 32 + r) * 2] = m_run; ML[(w * 32 + r) * 2 + 1] = lt; }
    __syncthreads();
    {
        const int q = t & 31, dg = t >> 5;
        float M = -1e30f;
#pragma unroll
        for (int ww = 0; ww < 8; ++ww) M = fmaxf(M, ML[(ww * 32 + q) * 2]);
        float L = 0.f, a[8];
#pragma unroll
        for (int e = 0; e < 8; ++e) a[e] = 0.f;
#pragma unroll
        for (int ww = 0; ww < 8; ++ww) {
            const float f = ex2(ML[(ww * 32 + q) * 2] - M); L += ML[(ww * 32 + q) * 2 + 1] * f;
#pragma unroll
            for (int e = 0; e < 8; ++e) a[e] += Ol[(ww * 128 + dg * 8 + e) * 32 + q] * f;
        }
        const float inv = frcp(L);
        u32x4 ov; ov.x = pk2(a[0] * inv, a[1] * inv); ov.y = pk2(a[2] * inv, a[3] * inv); ov.z = pk2(a[4] * inv, a[5] * inv); ov.w = pk2(a[6] * inv, a[7] * inv);
        *(u32x4*)(qrow + (size_t)q * 1024 + dg * 8) = ov;
    }
    __syncthreads();
}

DI void phase_p3(const Params& P, unsigned char* lds) {
    constexpr int N_RETP = 208, N_RETS = 32, N_AS = 64, N_AP = 1024;
    constexpr int NITEMS = N_RETP + N_RETS + N_AS + N_AP;
    int* s_item = (int*)(lds + LDS_BYTES - 16);
    unsigned* ctr = (unsigned*)(P.ws + WS_CTL);
    float qkb2;
    {
        const int lane = threadIdx.x & 63;
        float gq = fmaxf(fabsf(P.q_norm_g[lane]), fabsf(P.q_norm_g[lane + 64])), gk = fmaxf(fabsf(P.k_norm_g[lane]), fabsf(P.k_norm_g[lane + 64]));
#pragma unroll
        for (int o = 1; o < 64; o <<= 1) { gq = fmaxf(gq, __shfl_xor(gq, o)); gk = fmaxf(gk, __shfl_xor(gk, o)); }
        qkb2 = 128.f * gq * gk * 1.02f * ATT_SC;
    }
    for (;;) {
        if (threadIdx.x == 0) *s_item = (int)atomicAdd(ctr, 1u);
        __syncthreads();
        int it = *s_item;
        __syncthreads();
        if (it >= NITEMS) break;
        if (it < 256) { const int head = 7 - (it >> 7), rem = it & 127; attn_prompt_item(P, lds, rem & 3, head, 31 - (rem >> 2), qkb2); continue; } it -= 256;
        if (it < N_RETP) { ret_passC_prompt(P, lds, it / 13, it % 13); continue; } it -= N_RETP;
        if (it < N_RETS) { ret_sample_item(P, lds, it >> 2, it & 3); continue; } it -= N_RETS;
        if (it < N_AS) { attn_sample_item(P, lds, it >> 3, it & 7); continue; } it -= N_AS;
        { const int head = 5 - (it >> 7), rem = it & 127; attn_prompt_item(P, lds, rem & 3, head, 31 - (rem >> 2), qkb2); }
    }
}

DI void light_grid_barrier(unsigned* ctl, unsigned seam) {
    __syncthreads();
    if (threadIdx.x == 0) {
        const unsigned g = blockIdx.x & 7u, gs = (gridDim.x - g + 7u) >> 3, ng = gridDim.x < 8u ? gridDim.x : 8u;
        __threadfence();
        const unsigned old = __hip_atomic_fetch_add(ctl + 64 + 32 * g, 1u, __ATOMIC_RELAXED, __HIP_MEMORY_SCOPE_AGENT);
        if (old == seam * gs + gs - 1u) {
            __threadfence();
            const unsigned oldt = __hip_atomic_fetch_add(ctl + 32, 1u, __ATOMIC_RELAXED, __HIP_MEMORY_SCOPE_AGENT);
            if (oldt == seam * ng + ng - 1u) {
                __threadfence();
                for (unsigned j = 0; j < ng; ++j) __hip_atomic_store(ctl + 320 + 32 * j, seam + 1u, __ATOMIC_RELAXED, __HIP_MEMORY_SCOPE_AGENT);
            }
        }
        while (__hip_atomic_load(ctl + 320 + 32 * g, __ATOMIC_RELAXED, __HIP_MEMORY_SCOPE_AGENT) < seam + 1u) __builtin_amdgcn_s_sleep(16);
        __threadfence();
    }
    __syncthreads();
}

__global__ void __launch_bounds__(512) mega_fwd(Params P) {
    extern __shared__ __attribute__((aligned(16))) unsigned char lds[];
    cg::grid_group grid = cg::this_grid();
#define RUN_PHASE(K, BODY) do { if (P.ph_lo <= (K) && (K) < P.ph_hi) { BODY; if (P.coop && (K) + 1 < P.ph_hi) { if (P.pad) grid.sync();     light_grid_barrier((unsigned*)(P.ws + WS_CTL), (unsigned)(K)); } } } while (0)
    RUN_PHASE(0, (p0_rows(P, lds), p0_weights(P, lds), p0_misc(P)));
    RUN_PHASE(1, phase_p1(P, lds));
    RUN_PHASE(2, phase_p2(P, lds));
    RUN_PHASE(3, phase_p3(P, lds));
    RUN_PHASE(4, phase_p4(P, lds));
    RUN_PHASE(5, phase_p5(P, lds));
    RUN_PHASE(6, phase_p6(P, lds));
    RUN_PHASE(7, phase_p7(P, lds));
#undef RUN_PHASE
}

extern "C" void kernel_launch(void* const* d_in, const int* in_sizes, int n_in, void* d_out, int out_size, void* d_ws, size_t ws_size, hipStream_t stream) {
    static int grid_blocks = 0;
    if (!grid_blocks) {
        int dev = 0, cus = 0, per_cu = 0;
        (void)hipGetDevice(&dev);
        (void)hipDeviceGetAttribute(&cus, hipDeviceAttributeMultiprocessorCount, dev);
        (void)hipFuncSetAttribute((const void*)mega_fwd, hipFuncAttributeMaxDynamicSharedMemorySize, LDS_BYTES);
        (void)hipOccupancyMaxActiveBlocksPerMultiprocessor(&per_cu, (const void*)mega_fwd, 512, LDS_BYTES);
        if (per_cu < 1) { fprintf(stderr, "kernel_launch: occupancy query returned %d\n", per_cu); per_cu = 1; }
        grid_blocks = cus * per_cu;
        if (ws_size < WS_END) fprintf(stderr, "kernel_launch: workspace too small: %zu < %zu\n", ws_size, (size_t)WS_END);
        (void)hipGetLastError();
    }
    Params p{};
    p.x_prompt = (const float*)d_in[0]; p.x_sample = (const float*)d_in[1]; p.state_ret = (const float*)d_in[2]; p.cache_k = (const float*)d_in[3];
    p.cache_v = (const float*)d_in[4]; p.cache_logf = (const float*)d_in[5]; p.meta = (const float*)d_in[6]; p.norm1_g = (const float*)d_in[7];
    p.w_in = (const float*)d_in[8]; p.b_forget = (const float*)d_in[9]; p.q_norm_g = (const float*)d_in[10]; p.k_norm_g = (const float*)d_in[11];
    p.ret_gn_g = (const float*)d_in[12]; p.w_ret_out = (const float*)d_in[13]; p.w_fox_out = (const float*)d_in[14]; p.w_o = (const float*)d_in[15];
    p.norm2_g = (const float*)d_in[16]; p.w_ff1 = (const float*)d_in[17]; p.w_ff2 = (const float*)d_in[18];
    p.out = (float*)d_out; p.ws = (unsigned char*)d_ws; p.pad = 0;
    (void)hipMemsetAsync((unsigned char*)d_ws + WS_CTL, 0, 4096, stream);
#if MULTI_LAUNCH
    for (int ph = 0; ph < 8; ++ph) {
        p.ph_lo = ph; p.ph_hi = ph + 1; p.coop = 0;
        hipLaunchKernelGGL(mega_fwd, dim3(grid_blocks), dim3(512), LDS_BYTES, stream, p);
    }
#else
    p.ph_lo = 0; p.ph_hi = 8; p.coop = 1;
    void* args[] = {&p};
    hipError_t e = hipLaunchCooperativeKernel((void*)mega_fwd, dim3(grid_blocks), dim3(512), args, LDS_BYTES, stream);
    if (e != hipSuccess) fprintf(stderr, "cooperative launch failed: %s (grid %d)\n", hipGetErrorString(e), grid_blocks);
#endif
}
```

```cpp
#include <hip/hip_runtime.h>
#include <hip/hip_cooperative_groups.h>
#include <cstdio>
#include <cstdint>
namespace cg = cooperative_groups;

#ifndef MULTI_LAUNCH
#define MULTI_LAUNCH 0
#endif

typedef short bf16x8 __attribute__((ext_vector_type(8)));
typedef short s16x4 __attribute__((ext_vector_type(4)));
typedef float f32x16 __attribute__((ext_vector_type(16)));
typedef float f32x4 __attribute__((ext_vector_type(4)));
typedef float f32x2 __attribute__((ext_vector_type(2)));
typedef unsigned u32x4 __attribute__((ext_vector_type(4)));
typedef unsigned u32x2 __attribute__((ext_vector_type(2)));
typedef __bf16 bf2_t __attribute__((ext_vector_type(2)));
typedef unsigned short bf16_t;
#define DI __device__ __forceinline__
#define MFMA(a, b, c) __builtin_amdgcn_mfma_f32_32x32x16_bf16((a), (b), (c), 0, 0, 0)

constexpr int D = 1024, LP = 8320, OFF = 128, VAL0 = 112, MPR = 33280, MT = 33536, INW = 8200, DFF = 4096;
constexpr int NTM = MT / 256;
constexpr float EPS = 1e-6f, LOG2E = 1.4426950408889634f;
constexpr float ATT_SC = 0.08838834764831845f * 1.4426950408889634f;
constexpr int LDS_BYTES = 163840;

constexpr size_t SZ_ACT = (size_t)MT * 1024 * 2;
constexpr size_t WS_CTL = 0;
constexpr size_t WS_XN = 4096;
constexpr size_t WS_WIN = WS_XN + SZ_ACT;
constexpr size_t WS_WRET = WS_WIN + (size_t)8192 * 1024 * 2;
constexpr size_t WS_WFOX = WS_WRET + 2097152;
constexpr size_t WS_WO = WS_WFOX + 2097152;
constexpr size_t WS_WFF1 = WS_WO + 2097152;
constexpr size_t WS_WFF2 = WS_WFF1 + 8388608;
constexpr size_t WS_RQ = WS_WFF2 + 8388608;
constexpr size_t WS_RK = WS_RQ + SZ_ACT / 2;
constexpr size_t WS_RV = WS_RK + SZ_ACT / 2;
constexpr size_t WS_RG = WS_RV + SZ_ACT;
constexpr size_t WS_FQ = WS_RG + SZ_ACT;
constexpr size_t WS_FK = WS_FQ + SZ_ACT;
constexpr size_t WS_VT = WS_FK + SZ_ACT;
constexpr size_t WS_LOGF = WS_VT + (size_t)4 * 8 * 128 * LP * 2;
constexpr size_t WS_NCKP = WS_LOGF + (size_t)MT * 8 * 4;
constexpr size_t WS_NCKS = WS_NCKP + (size_t)32 * LP * 4;
constexpr size_t WS_ROPE = WS_NCKS + (size_t)64 * 4128 * 4;
constexpr size_t WS_SSQ = WS_ROPE + (size_t)LP * 64 * 8;
constexpr size_t WS_GAS = WS_SSQ + (size_t)MT * 8 * 4;
constexpr size_t WS_GBS = WS_GAS + 524288;
constexpr size_t WS_SSQS = WS_GBS + 524288;
constexpr size_t WS_END = WS_SSQS + 32768;
constexpr size_t WS_TG = WS_XN;
constexpr size_t WS_M = WS_RV;
constexpr size_t WS_A2 = WS_FK;
constexpr size_t WS_U = WS_RQ;
static_assert(WS_END <= (size_t)512 * 1024 * 1024, "workspace too large");
static_assert(WS_U + (size_t)MT * 4096 * 2 == WS_FK, "U alias");

constexpr size_t O_Y = 0, O_YS = 33554432, O_PST = O_YS + 262144, O_PK = O_PST + 524288, O_PV = O_PK + 33619968, O_PLF = O_PV + 33619968,
                 O_SST = O_PLF + 262656, O_SK = O_SST + 1048576, O_SV = O_SK + 262144, O_SLF = O_SV + 262144;

struct Params {
    const float* x_prompt; const float* x_sample; const float* state_ret; const float* cache_k; const float* cache_v; const float* cache_logf;
    const float* meta; const float* norm1_g; const float* w_in; const float* b_forget; const float* q_norm_g; const float* k_norm_g; const float* ret_gn_g;
    const float* w_ret_out; const float* w_fox_out; const float* w_o; const float* norm2_g; const float* w_ff1; const float* w_ff2;
    float* out; unsigned char* ws; int ph_lo, ph_hi, coop, pad;
};

DI unsigned pk2(float a, float b) { f32x2 v = {a, b}; bf2_t r = __builtin_convertvector(v, bf2_t); return __builtin_bit_cast(unsigned, r); }
DI bf16_t f2bf(float a) { return (bf16_t)(pk2(a, 0.f) & 0xffffu); }
DI float bflo(unsigned u) { return __uint_as_float(u << 16); }
DI float bfhi(unsigned u) { return __uint_as_float(u & 0xffff0000u); }
DI float bf2f(bf16_t u) { return __uint_as_float(((unsigned)u) << 16); }
DI int crow(int i, int h) { return (i & 3) + 8 * (i >> 2) + 4 * h; }
DI float ex2(float x) { return __builtin_amdgcn_exp2f(x); }
DI float frcp(float x) { return __builtin_amdgcn_rcpf(x); }
DI float frsq(float x) { return __builtin_amdgcn_rsqf(x); }
DI bf16x8 pack8(const f32x16& x, int s) {
    u32x4 p; p.x = pk2(x[8 * s], x[8 * s + 1]); p.y = pk2(x[8 * s + 2], x[8 * s + 3]); p.z = pk2(x[8 * s + 4], x[8 * s + 5]); p.w = pk2(x[8 * s + 6], x[8 * s + 7]);
    return __builtin_bit_cast(bf16x8, p);
}
DI bf16x8 cat4(s16x4 lo, s16x4 hi) { return __builtin_shufflevector(lo, hi, 0, 1, 2, 3, 4, 5, 6, 7); }
DI float wave_sum(float v) {
#pragma unroll
    for (int o = 1; o < 64; o <<= 1) v += __shfl_xor(v, o);
    return v;
}
DI float half_sum32(float v) {
#pragma unroll
    for (int o = 1; o < 32; o <<= 1) v += __shfl_xor(v, o);
    return v;
}
DI void decode_row(int r, int& samp, int& b, int& p) {
    if (r < MPR) { samp = 0; b = r / LP; p = r - b * LP; } else { samp = 1; const int s = r - MPR; b = s >> 5; p = s & 31; }
}
DI int opaque_tid() { int t = threadIdx.x; asm volatile("" : "+v"(t)); return t; }
DI f32x16 zero16() { f32x16 z; for (int i = 0; i < 16; ++i) z[i] = 0.f; return z; }

DI void p0_rows(const Params& P, unsigned char* lds) {
    float* wffT = (float*)lds;
    const int t = opaque_tid();
#pragma unroll
    for (int i = 0; i < 16; ++i) { const int idx = t + 512 * i; const int c = idx >> 3, h = idx & 7; wffT[h * 1024 + c] = P.w_in[(size_t)c * INW + 6144 + h]; }
    __syncthreads();
    const int lane = t & 63, wave = t >> 6;
    bf16_t* XN = (bf16_t*)(P.ws + WS_XN); float* LOGF = (float*)(P.ws + WS_LOGF);
    for (int r = blockIdx.x * 8 + wave; r < MT; r += gridDim.x * 8) {
        int samp, b, p; decode_row(r, samp, b, p);
        const float* src = nullptr;
        if (samp) src = P.x_sample + (size_t)(r - MPR) * D;
        else if (p >= OFF) src = P.x_prompt + ((size_t)b * 8192 + (p - OFF)) * D;
        else if (p >= VAL0) src = P.meta + (size_t)(p - VAL0) * D;
        f32x4 v[4]; float ss = 0.f;
#pragma unroll
        for (int j = 0; j < 4; ++j) {
            if (src) v[j] = *(const f32x4*)(src + 4 * lane + 256 * j); else v[j] = (f32x4){0.f, 0.f, 0.f, 0.f};
            ss += v[j].x * v[j].x + v[j].y * v[j].y + v[j].z * v[j].z + v[j].w * v[j].w;
        }
        ss = wave_sum(ss);
        const float rstd = frsq(ss * (1.f / 1024.f) + EPS);
        float dot[8];
#pragma unroll
        for (int h = 0; h < 8; ++h) dot[h] = 0.f;
#pragma unroll
        for (int j = 0; j < 4; ++j) {
            const f32x4 g = *(const f32x4*)(P.norm1_g + 4 * lane + 256 * j);
            v[j] = v[j] * rstd * g;
            u32x2 o; o.x = pk2(v[j].x, v[j].y); o.y = pk2(v[j].z, v[j].w);
            *(u32x2*)(XN + (size_t)r * D + 4 * lane + 256 * j) = o;
#pragma unroll
            for (int h = 0; h < 8; ++h) { const f32x4 w = *(const f32x4*)(wffT + h * 1024 + 4 * lane + 256 * j); dot[h] += v[j].x * w.x + v[j].y * w.y + v[j].z * w.z + v[j].w * w.w; }
        }
#pragma unroll
        for (int h = 0; h < 8; ++h) dot[h] = wave_sum(dot[h]);
        float mine = dot[0];
#pragma unroll
        for (int h = 1; h < 8; ++h) mine = (lane == h) ? dot[h] : mine;
        if (lane < 8) {
            const float vv = mine + P.b_forget[lane];
            float lf = fminf(vv, 0.f) - log1pf(__expf(-fabsf(vv)));
            if (!samp && p < VAL0) lf = 0.f;
            LOGF[(size_t)r * 8 + lane] = lf;
            if (samp) P.out[O_SLF + (size_t)(r - MPR) * 8 + lane] = lf;
            else if (p >= VAL0) P.out[O_PLF + ((size_t)b * 8208 + (p - VAL0)) * 8 + lane] = lf;
        }
    }
    __syncthreads();
}

DI void transpose_item(const float* W, int ldw, int col0, int K, bf16_t* WT, int n0, int k0, float* tile) {
    const int t = opaque_tid(); const int nn = t & 63, kb = t >> 6;
#pragma unroll
    for (int i = 0; i < 8; ++i) { const int kk = kb + 8 * i; tile[kk * 65 + nn] = W[(size_t)(k0 + kk) * ldw + col0 + nn]; }
    __syncthreads();
    const int n = t >> 3, kc = t & 7;
    float f[8];
#pragma unroll
    for (int e = 0; e < 8; ++e) f[e] = tile[(8 * kc + e) * 65 + n];
    u32x4 o; o.x = pk2(f[0], f[1]); o.y = pk2(f[2], f[3]); o.z = pk2(f[4], f[5]); o.w = pk2(f[6], f[7]);
    *(u32x4*)(WT + (size_t)(n0 + n) * K + k0 + 8 * kc) = o;
    __syncthreads();
}

DI void p0_weights(const Params& P, unsigned char* lds) {
    float* tile = (float*)lds;
    constexpr int I0 = 16 * 128, I1 = 256, I4 = 16 * 64, I5 = 64 * 16;
    constexpr int NIT = I0 + 3 * I1 + I4 + I5;
    for (int it = blockIdx.x; it < NIT; it += gridDim.x) {
        int r = it;
        if (r < I0) { const int kt = r / 128, nt = r % 128; const int n0 = nt * 64; transpose_item(P.w_in, INW, n0 + (n0 >= 6144 ? 8 : 0), 1024, (bf16_t*)(P.ws + WS_WIN), n0, kt * 64, tile); continue; } r -= I0;
        if (r < I1) { transpose_item(P.w_ret_out, 1024, (r % 16) * 64, 1024, (bf16_t*)(P.ws + WS_WRET), (r % 16) * 64, (r / 16) * 64, tile); continue; } r -= I1;
        if (r < I1) { transpose_item(P.w_fox_out, 1024, (r % 16) * 64, 1024, (bf16_t*)(P.ws + WS_WFOX), (r % 16) * 64, (r / 16) * 64, tile); continue; } r -= I1;
        if (r < I1) { transpose_item(P.w_o, 1024, (r % 16) * 64, 1024, (bf16_t*)(P.ws + WS_WO), (r % 16) * 64, (r / 16) * 64, tile); continue; } r -= I1;
        if (r < I4) { transpose_item(P.w_ff1, 4096, (r % 64) * 64, 1024, (bf16_t*)(P.ws + WS_WFF1), (r % 64) * 64, (r / 64) * 64, tile); continue; } r -= I4;
        transpose_item(P.w_ff2, 1024, (r % 16) * 64, 4096, (bf16_t*)(P.ws + WS_WFF2), (r % 16) * 64, (r / 16) * 64, tile);
    }
}

DI void p0_misc(const Params& P) {
    f32x2* ROPE = (f32x2*)(P.ws + WS_ROPE);
    for (int idx = blockIdx.x * 512 + threadIdx.x; idx < LP * 64; idx += gridDim.x * 512) {
        const int pp = idx >> 6, c = idx & 63;
        const float pos = (float)(pp - 128);
        const float inv = exp2f(-(float)c * (13.287712379549449f / 64.f));
        const float ang = pos * inv;
        double td = (double)ang * 0.15915494309189535; td -= __builtin_rint(td);
        const float tf = (float)td;
        f32x2 cs; cs.x = __builtin_amdgcn_cosf(tf); cs.y = __builtin_amdgcn_sinf(tf);
        ROPE[idx] = cs;
    }
}

#define AS_GLOBAL __attribute__((address_space(1)))
#define AS_LDS __attribute__((address_space(3)))
DI void dma16(const void* g, unsigned char* l) { __builtin_amdgcn_global_load_lds((const AS_GLOBAL unsigned*)g, (AS_LDS unsigned*)l, 16, 0, 0); }
template <int NBW>
DI void gemm_mainloop(f32x16 (&acc)[2][NBW], const bf16_t* A, size_t lda, int m0, const bf16_t* Bt, size_t ldb, int n0, int K, unsigned char* lds, bool pre = false, bool only_issue = false) {
    constexpr int STAGE = 65536, BOFF = 32768;
    const int t = opaque_tid(), w = t >> 6, lane = t & 63, r = lane & 31, hh = lane >> 5, wm = w >> 1, wn = w & 1;
    const int drow = w * 8 + (lane >> 3);
    const int lchunk = (lane & 7) ^ ((drow >> 1) & 7);
    const bf16_t* ap = A + (size_t)(m0 + drow) * lda + lchunk * 8;
    const bf16_t* bp = Bt + (size_t)n0 * ldb + lchunk * 8;
    size_t bro[NBW];
#pragma unroll
    for (int j = 0; j < NBW; ++j) {
        const int rho = 64 * j + drow; const int wnh = rho / (32 * NBW), wi = rho % (32 * NBW);
        bro[j] = (size_t)(wnh * 32 * NBW + NBW * (wi & 31) + (wi >> 5)) * ldb;
    }
    unsigned char* ldst = lds + w * 1024 + lane * 16;
#define GEMM_ISSUE(KT, ST) do { const int k1_ = (KT) << 6; unsigned char* d_ = ldst + (ST) * STAGE; \
        _Pragma("unroll") for (int j_ = 0; j_ < 4; ++j_) dma16(ap + (size_t)(64 * j_) * lda + k1_, d_ + j_ * 8192); \
        _Pragma("unroll") for (int j_ = 0; j_ < NBW; ++j_) dma16(bp + bro[j_] + k1_, d_ + BOFF + j_ * 8192); } while (0)
    if (!pre) GEMM_ISSUE(0, 0);
    if (only_issue) return;
    __syncthreads();
    const int nk = K >> 6;
    const int xr = (r >> 1) & 7;
    int xo[4];
#pragma unroll
    for (int s = 0; s < 4; ++s) xo[s] = ((2 * s + hh) ^ xr) << 4;
    const int aofs = (wm * 64 + r) * 128;
    const int bofs = BOFF + (wn * 32 * NBW + r) * 128;
#pragma unroll 1
    for (int kt = 0; kt < nk; ++kt) {
        const unsigned char* st = lds + (kt & 1) * STAGE;
#pragma unroll
        for (int s = 0; s < 4; ++s) {
            if (s == 1 && kt + 1 < nk) GEMM_ISSUE(kt + 1, (kt + 1) & 1);
            bf16x8 a[2], b[NBW];
#pragma unroll
            for (int mb = 0; mb < 2; ++mb) a[mb] = *(const bf16x8*)(st + aofs + mb * 4096 + xo[s]);
#pragma unroll
            for (int nb = 0; nb < NBW; ++nb) b[nb] = *(const bf16x8*)(st + bofs + nb * 4096 + xo[s]);
#pragma unroll
            for (int mb = 0; mb < 2; ++mb)
#pragma unroll
                for (int nb = 0; nb < NBW; ++nb) acc[mb][nb] = MFMA(a[mb], b[nb], acc[mb][nb]);
        }
        __syncthreads();
    }
#undef GEMM_ISSUE
}

DI void epi_p1(const Params& P, f32x16 (&acc)[2][4], int m0, int n0) {
    const int t = opaque_tid(), w = t >> 6, lane = t & 63, r = lane & 31, hh = lane >> 5, wm = w >> 1, wn = w & 1;
    const int seg = (n0 + wn * 128) >> 7;
    unsigned char* ws = P.ws; float* out = P.out;
    const int rbase = m0 + wm * 64 + 4 * hh;
    const int c4 = 4 * r;
    if (seg < 8) {
        const bool isk = seg >= 4; const int head = seg & 3;
        bf16_t* dst = (bf16_t*)(ws + (isk ? WS_RK : WS_RQ)); const float scl = isk ? 0.08838834764831845f : 1.f;
        const float* rope = (const float*)(ws + WS_ROPE);
        const float sgn = (r < 16) ? -1.f : 1.f; const int f4 = 4 * (r & 15);
#pragma unroll
        for (int mb = 0; mb < 2; ++mb)
#pragma unroll
            for (int g = 0; g < 4; ++g) {
                const int rowb = rbase + mb * 32 + 8 * g; int samp, b, p0; decode_row(rowb, samp, b, p0);
                const int ridx0 = samp ? 4224 + p0 : p0;
#pragma unroll
                for (int e = 0; e < 4; ++e) {
                    const int i = 4 * g + e; const size_t row = rowb + e;
                    const f32x4 cs0 = *(const f32x4*)(rope + ((size_t)(ridx0 + e) * 64 + f4) * 2), cs1 = *(const f32x4*)(rope + ((size_t)(ridx0 + e) * 64 + f4) * 2 + 4);
                    const float cc[4] = {cs0.x, cs0.z, cs1.x, cs1.z}, sn[4] = {cs0.y, cs0.w, cs1.y, cs1.w};
                    float o[4];
#pragma unroll
                    for (int nb = 0; nb < 4; ++nb) { const float v = acc[mb][nb][i]; const float pv = __shfl_xor(v, 16); o[nb] = (v * cc[nb] + sgn * pv * sn[nb]) * scl; }
                    u32x2 ov; ov.x = pk2(o[0], o[1]); ov.y = pk2(o[2], o[3]);
                    __builtin_nontemporal_store(ov, (u32x2*)(dst + row * 512 + head * 128 + c4));
                }
            }
    } else if (seg < 24) {
        bf16_t* dst = (bf16_t*)(ws + (seg < 16 ? WS_RV : WS_RG)); const int cb = (seg & 7) * 128 + c4;
#pragma unroll
        for (int mb = 0; mb < 2; ++mb)
#pragma unroll
            for (int i = 0; i < 16; ++i) {
                const size_t row = rbase + mb * 32 + (i & 3) + 8 * (i >> 2);
                u32x2 ov; ov.x = pk2(acc[mb][0][i], acc[mb][1][i]); ov.y = pk2(acc[mb][2][i], acc[mb][3][i]);
                __builtin_nontemporal_store(ov, (u32x2*)(dst + row * 1024 + cb));
            }
    } else if (seg < 40) {
        const bool isk = seg >= 32; const int head = seg & 7;
        const f32x4 gv = *(const f32x4*)((isk ? P.k_norm_g : P.q_norm_g) + c4);
        bf16_t* dst = (bf16_t*)(ws + (isk ? WS_FK : WS_FQ));
#pragma unroll
        for (int mb = 0; mb < 2; ++mb)
#pragma unroll
            for (int g = 0; g < 4; ++g) {
                const int rowb = rbase + mb * 32 + 8 * g; int samp, b, p0; decode_row(rowb, samp, b, p0);
#pragma unroll
                for (int e = 0; e < 4; ++e) {
                    const int i = 4 * g + e; const size_t row = rowb + e; const int p = p0 + e;
                    float ss = 0.f;
#pragma unroll
                    for (int nb = 0; nb < 4; ++nb) ss += acc[mb][nb][i] * acc[mb][nb][i];
                    ss = half_sum32(ss);
                    const float rstd = frsq(ss * (1.f / 128.f) + EPS);
                    f32x4 y; y.x = acc[mb][0][i] * rstd * gv.x; y.y = acc[mb][1][i] * rstd * gv.y; y.z = acc[mb][2][i] * rstd * gv.z; y.w = acc[mb][3][i] * rstd * gv.w;
                    u32x2 ov; ov.x = pk2(y.x, y.y); ov.y = pk2(y.z, y.w);
                    __builtin_nontemporal_store(ov, (u32x2*)(dst + row * 1024 + head * 128 + c4));
                    if (isk) {
                        if (samp) __builtin_nontemporal_store(y, (f32x4*)(out + O_SK + ((size_t)(b * 32 + p) * 8 + head) * 128 + c4));
                        else if (p >= VAL0) __builtin_nontemporal_store(y, (f32x4*)(out + O_PK + (((size_t)b * 8208 + (p - VAL0)) * 8 + head) * 128 + c4));
                    }
                }
            }
    } else if (seg < 48) {
        const int head = seg & 7; bf16_t* VT = (bf16_t*)(ws + WS_VT);
#pragma unroll
        for (int mb = 0; mb < 2; ++mb)
#pragma unroll
            for (int g = 0; g < 4; ++g) {
                const int rowb = rbase + mb * 32 + 8 * g; int samp, b, p0; decode_row(rowb, samp, b, p0);
#pragma unroll
                for (int e = 0; e < 4; ++e) {
                    const int i = 4 * g + e; const int p = p0 + e;
                    f32x4 y; y.x = acc[mb][0][i]; y.y = acc[mb][1][i]; y.z = acc[mb][2][i]; y.w = acc[mb][3][i];
                    if (samp) __builtin_nontemporal_store(y, (f32x4*)(out + O_SV + ((size_t)(b * 32 + p) * 8 + head) * 128 + c4));
                    else if (p >= VAL0) __builtin_nontemporal_store(y, (f32x4*)(out + O_PV + (((size_t)b * 8208 + (p - VAL0)) * 8 + head) * 128 + c4));
                }
                if (!samp) {
#pragma unroll
                    for (int nb = 0; nb < 4; ++nb) {
                        u32x2 o; o.x = pk2(acc[mb][nb][4 * g], acc[mb][nb][4 * g + 1]); o.y = pk2(acc[mb][nb][4 * g + 2], acc[mb][nb][4 * g + 3]);
                        *(u32x2*)(VT + ((size_t)((b * 8 + head) * 128 + c4 + nb)) * LP + p0) = o;
                    }
                }
            }
    } else {
        const bool isb = seg >= 56; const int cb = (seg & 7) * 128 + c4;
        bf16_t* dp = (bf16_t*)out + (isb ? (size_t)33554432 : 0);
        bf16_t* dsm = (bf16_t*)(ws + (isb ? WS_GBS : WS_GAS));
#pragma unroll
        for (int mb = 0; mb < 2; ++mb)
#pragma unroll
            for (int g = 0; g < 4; ++g) {
                const int rowb = rbase + mb * 32 + 8 * g; int samp, b, p0; decode_row(rowb, samp, b, p0);
#pragma unroll
                for (int e = 0; e < 4; ++e) {
                    const int i = 4 * g + e; const int p = p0 + e;
                    bf16_t* d = nullptr;
                    if (samp) d = dsm + (size_t)(b * 32 + p) * 1024; else if (p >= OFF) d = dp + ((size_t)b * 8192 + (p - OFF)) * 1024;
                    if (d) {
                        float s[4];
#pragma unroll
                        for (int nb = 0; nb < 4; ++nb) s[nb] = frcp(1.f + ex2(-LOG2E * acc[mb][nb][i]));
                        u32x2 ov; ov.x = pk2(s[0], s[1]); ov.y = pk2(s[2], s[3]);
                        __builtin_nontemporal_store(ov, (u32x2*)(d + cb));
                    }
                }
            }
    }
}

DI void phase_p1(const Params& P, unsigned char* lds) {
    const bf16_t* A = (const bf16_t*)(P.ws + WS_XN); const bf16_t* Bt = (const bf16_t*)(P.ws + WS_WIN);
    constexpr int NTN = 32;
    bool pre = false;
#pragma unroll 1
    for (int tile = blockIdx.x; tile < NTM * NTN; tile += gridDim.x) {
        const int mt = tile / NTN, nt = tile % NTN;
        f32x16 acc[2][4];
#pragma unroll
        for (int a = 0; a < 2; ++a)
#pragma unroll
            for (int b = 0; b < 4; ++b) acc[a][b] = zero16();
        gemm_mainloop<4>(acc, A, 1024, mt * 256, Bt, 1024, nt * 256, 1024, lds, pre);
        { const int tn = tile + gridDim.x; pre = tn < NTM * NTN; if (pre) { const int mtn = tn / NTN, ntn_ = tn % NTN; f32x16 (&dummy)[2][4] = acc; gemm_mainloop<4>(dummy, A, 1024, mtn * 256, Bt, 1024, ntn_ * 256, 1024, lds, false, true); } }
        epi_p1(P, acc, mt * 256, nt * 256);
    }
}

DI void small_tile(const bf16_t* A, size_t lda, int a0, const bf16_t* Bt, size_t ldb, int b0, int K, float* ctile, float* red) {
    const int t = opaque_tid(), w = t >> 6, lane = t & 63, r = lane & 31, hh = lane >> 5;
    const int kper = K >> 3;
    const bf16_t* ap = A + (size_t)(a0 + r) * lda + w * kper + 8 * hh;
    const bf16_t* bp = Bt + (size_t)(b0 + r) * ldb + w * kper + 8 * hh;
    f32x16 acc = zero16();
#pragma unroll 4
    for (int k = 0; k < kper; k += 16) acc = MFMA(*(const bf16x8*)(ap + k), *(const bf16x8*)(bp + k), acc);
#pragma unroll
    for (int i = 0; i < 16; ++i) red[w * 1024 + i * 64 + lane] = acc[i];
    __syncthreads();
#pragma unroll
    for (int q = 0; q < 2; ++q) {
        const int e = t + 512 * q; float s = 0.f;
#pragma unroll
        for (int ww = 0; ww < 8; ++ww) s += red[ww * 1024 + e];
        const int i = e >> 6, ln = e & 63;
        ctile[crow(i, ln >> 5) * 33 + (ln & 31)] = s;
    }
    __syncthreads();
}

DI void phase_p4(const Params& P, unsigned char* lds) {
    const bf16_t* RO = (const bf16_t*)(P.ws + WS_RG); const bf16_t* FO = (const bf16_t*)(P.ws + WS_FQ);
    const bf16_t* W1 = (const bf16_t*)(P.ws + WS_WRET); const bf16_t* W2 = (const bf16_t*)(P.ws + WS_WFOX);
    bf16_t* M = (bf16_t*)(P.ws + WS_M);
    const bf16_t* GAp = (const bf16_t*)P.out; const bf16_t* GBp = GAp + (size_t)33554432;
    const bf16_t* GAs = (const bf16_t*)(P.ws + WS_GAS); const bf16_t* GBs = (const bf16_t*)(P.ws + WS_GBS);
    const int t = opaque_tid(), w = t >> 6, lane = t & 63, r = lane & 31, hh = lane >> 5, wm = w >> 1, wn = w & 1;
    constexpr int NTN = 8;
    bool pre = false;
#pragma unroll 1
    for (int tile = blockIdx.x; tile < 128 * NTN; tile += gridDim.x) {
        const int mt = tile / NTN, nt = tile % NTN; const int m0 = (mt >> 5) * LP + OFF + (mt & 31) * 256, n0 = nt * 128;
        f32x16 a1[2][2], a2[2][2];
#pragma unroll
        for (int a = 0; a < 2; ++a)
#pragma unroll
            for (int b = 0; b < 2; ++b) { a1[a][b] = zero16(); a2[a][b] = zero16(); }
        gemm_mainloop<2>(a1, RO, 1024, m0, W1, 1024, n0, 1024, lds, pre);
        gemm_mainloop<2>(a2, FO, 1024, m0, W2, 1024, n0, 1024, lds);
        { const int tn = tile + gridDim.x; pre = tn < 128 * NTN; if (pre) { const int mtn = tn / NTN, ntn_ = tn % NTN; gemm_mainloop<2>(a1, RO, 1024, (mtn >> 5) * LP + OFF + (mtn & 31) * 256, W1, 1024, ntn_ * 128, 1024, lds, false, true); } }
        const int col = n0 + wn * 64 + 2 * r;
        const size_t crow0 = (size_t)mt * 256 + wm * 64 + 4 * hh;
#pragma unroll
        for (int mb = 0; mb < 2; ++mb) {
            unsigned ua[16], ub[16];
#pragma unroll
            for (int i = 0; i < 16; ++i) {
                const size_t ci = (crow0 + mb * 32 + (i & 3) + 8 * (i >> 2)) * 1024 + col;
                ua[i] = *(const unsigned*)(GAp + ci); ub[i] = *(const unsigned*)(GBp + ci);
            }
#pragma unroll
            for (int i = 0; i < 16; ++i) {
                const size_t row = (size_t)m0 + wm * 64 + mb * 32 + crow(i, hh);
                const float m0v = bflo(ua[i]) * a1[mb][0][i] + bflo(ub[i]) * a2[mb][0][i];
                const float m1v = bfhi(ua[i]) * a1[mb][1][i] + bfhi(ub[i]) * a2[mb][1][i];
                __builtin_nontemporal_store(pk2(m0v, m1v), (unsigned*)(M + row * 1024 + col));
            }
        }
    }
    {
        float* red = (float*)lds; float* c1 = (float*)(lds + 32768); float* c2 = (float*)(lds + 32768 + 4352);
#pragma unroll 1
        for (int pc = blockIdx.x; pc < 8 * 32; pc += gridDim.x) {
            const int rg = pc >> 5, cg = pc & 31;
            small_tile(RO, 1024, MPR + 32 * rg, W1, 1024, 32 * cg, 1024, c1, red);
            small_tile(FO, 1024, MPR + 32 * rg, W2, 1024, 32 * cg, 1024, c2, red);
            const int rl = t >> 4, cl = (t & 15) * 2; const int srow = 32 * rg + rl, col = 32 * cg + cl;
            const unsigned ua = *(const unsigned*)(GAs + (size_t)srow * 1024 + col), ub = *(const unsigned*)(GBs + (size_t)srow * 1024 + col);
            const float m0v = bflo(ua) * c1[rl * 33 + cl] + bflo(ub) * c2[rl * 33 + cl];
            const float m1v = bfhi(ua) * c1[rl * 33 + cl + 1] + bfhi(ub) * c2[rl * 33 + cl + 1];
            __builtin_nontemporal_store(pk2(m0v, m1v), (unsigned*)(M + (size_t)(MPR + srow) * 1024 + col));
            __syncthreads();
        }
    }
}

DI void phase_p5(const Params& P, unsigned char* lds) {
    const bf16_t* M = (const bf16_t*)(P.ws + WS_M); const bf16_t* W = (const bf16_t*)(P.ws + WS_WO);
    bf16_t* A2 = (bf16_t*)(P.ws + WS_A2); float* SSQ = (float*)(P.ws + WS_SSQ);
    const int t = opaque_tid(), w = t >> 6, lane = t & 63, r = lane & 31, hh = lane >> 5, wm = w >> 1, wn = w & 1;
    constexpr int NTN = 4;
    bool pre = false;
#pragma unroll 1
    for (int tile = blockIdx.x; tile < 128 * NTN; tile += gridDim.x) {
        const int mt = tile / NTN, nt = tile % NTN; const int m0 = (mt >> 5) * LP + OFF + (mt & 31) * 256, n0 = nt * 256;
        f32x16 acc[2][4];
#pragma unroll
        for (int a = 0; a < 2; ++a)
#pragma unroll
            for (int b = 0; b < 4; ++b) acc[a][b] = zero16();
        gemm_mainloop<4>(acc, M, 1024, m0, W, 1024, n0, 1024, lds, pre);
        { const int tn = tile + gridDim.x; pre = tn < 128 * NTN; if (pre) { const int mtn = tn / NTN, ntn_ = tn % NTN; f32x16 (&dummy)[2][4] = acc; gemm_mainloop<4>(dummy, M, 1024, (mtn >> 5) * LP + OFF + (mtn & 31) * 256, W, 1024, ntn_ * 256, 1024, lds, false, true); } }
        const int col = n0 + wn * 128 + 4 * r;
        const f32x4 g2 = *(const f32x4*)(P.norm2_g + col);
        const size_t crow0 = (size_t)mt * 256 + wm * 64 + 4 * hh;
#pragma unroll
        for (int mb = 0; mb < 2; ++mb) {
#pragma unroll
          for (int hf = 0; hf < 2; ++hf) {
            f32x4 xv[16];
#pragma unroll
            for (int i = 8 * hf; i < 8 * hf + 8; ++i) xv[i] = *(const f32x4*)(P.x_prompt + (crow0 + mb * 32 + (i & 3) + 8 * (i >> 2)) * 1024 + col);
#pragma unroll
            for (int i = 8 * hf; i < 8 * hf + 8; ++i) {
                const size_t lr = mb * 32 + (i & 3) + 8 * (i >> 2); const size_t row = (size_t)m0 + wm * 64 + 4 * hh + lr;
                f32x4 h2; h2.x = xv[i].x + acc[mb][0][i]; h2.y = xv[i].y + acc[mb][1][i]; h2.z = xv[i].z + acc[mb][2][i]; h2.w = xv[i].w + acc[mb][3][i];
                __builtin_nontemporal_store(h2, (f32x4*)(P.out + O_Y + (crow0 + lr) * 1024 + col));
                u32x2 ov; ov.x = pk2(h2.x * g2.x, h2.y * g2.y); ov.y = pk2(h2.z * g2.z, h2.w * g2.w);
                __builtin_nontemporal_store(ov, (u32x2*)(A2 + row * 1024 + col));
                float ss = (h2.x * h2.x + h2.y * h2.y) + (h2.z * h2.z + h2.w * h2.w);
                ss = half_sum32(ss);
                if (r == 0) SSQ[row * 8 + nt * 2 + wn] = ss;
            }
          }
        }
    }
    {
        float* red = (float*)lds; float* c1 = (float*)(lds + 32768); float* SSQS = (float*)(P.ws + WS_SSQS);
#pragma unroll 1
        for (int pc = blockIdx.x; pc < 8 * 32; pc += gridDim.x) {
            const int rg = pc >> 5, cg = pc & 31;
            small_tile(M, 1024, MPR + 32 * rg, W, 1024, 32 * cg, 1024, c1, red);
            const int rl = t >> 4, cl = (t & 15) * 2; const int srow = 32 * rg + rl, col = 32 * cg + cl;
            const f32x2 xv = *(const f32x2*)(P.x_sample + (size_t)srow * 1024 + col);
            f32x2 h2; h2.x = xv.x + c1[rl * 33 + cl]; h2.y = xv.y + c1[rl * 33 + cl + 1];
            __builtin_nontemporal_store(h2, (f32x2*)(P.out + O_YS + (size_t)srow * 1024 + col));
            const f32x2 g2 = *(const f32x2*)(P.norm2_g + col);
            __builtin_nontemporal_store(pk2(h2.x * g2.x, h2.y * g2.y), (unsigned*)(A2 + (size_t)(MPR + srow) * 1024 + col));
            float ss = h2.x * h2.x + h2.y * h2.y;
#pragma unroll
            for (int o = 1; o < 16; o <<= 1) ss += __shfl_xor(ss, o);
            if ((t & 15) == 0) SSQS[srow * 32 + cg] = ss;
            __syncthreads();
        }
    }
}

DI void phase_p6(const Params& P, unsigned char* lds) {
    const bf16_t* A2 = (const bf16_t*)(P.ws + WS_A2); const bf16_t* W = (const bf16_t*)(P.ws + WS_WFF1);
    bf16_t* U = (bf16_t*)(P.ws + WS_U); const float* SSQ = (const float*)(P.ws + WS_SSQ);
    const int t = opaque_tid(), w = t >> 6, lane = t & 63, r = lane & 31, hh = lane >> 5, wm = w >> 1, wn = w & 1;
    constexpr int NTN = 16;
    bool pre = false; int rtpar = 0;
#pragma unroll 1
    for (int tile = blockIdx.x; tile < 128 * NTN; tile += gridDim.x) {
        const int mt = tile / NTN, nt = tile % NTN; const int m0 = (mt >> 5) * LP + OFF + (mt & 31) * 256, n0 = nt * 256;
        f32x16 acc[2][4];
#pragma unroll
        for (int a = 0; a < 2; ++a)
#pragma unroll
            for (int b = 0; b < 4; ++b) acc[a][b] = zero16();
        {
            float* rt = (float*)(lds + 131072 + (rtpar & 1) * 1024);
            if (t < 256) {
                const size_t row = (size_t)m0 + t;
                const f32x4 s0 = *(const f32x4*)(SSQ + row * 8), s1 = *(const f32x4*)(SSQ + row * 8 + 4);
                const float ss = ((s0.x + s0.y) + (s0.z + s0.w)) + ((s1.x + s1.y) + (s1.z + s1.w));
                rt[t] = frsq(ss * (1.f / 1024.f) + EPS);
            }
        }
        gemm_mainloop<4>(acc, A2, 1024, m0, W, 1024, n0, 1024, lds, pre);
        { const int tn = tile + gridDim.x; pre = tn < 128 * NTN; if (pre) { const int mtn = tn / NTN, ntn_ = tn % NTN; f32x16 (&dummy)[2][4] = acc; gemm_mainloop<4>(dummy, A2, 1024, (mtn >> 5) * LP + OFF + (mtn & 31) * 256, W, 1024, ntn_ * 256, 1024, lds, false, true); } }
        const int col = n0 + wn * 128 + 4 * r;
#pragma unroll
        for (int mb = 0; mb < 2; ++mb)
#pragma unroll
            for (int i = 0; i < 16; ++i) {
                const size_t row = m0 + wm * 64 + mb * 32 + crow(i, hh);
                const float rstd = ((const float*)(lds + 131072 + (rtpar & 1) * 1024))[wm * 64 + mb * 32 + crow(i, hh)];
                float u[4];
#pragma unroll
                for (int nb = 0; nb < 4; ++nb) { const float v = fmaxf(acc[mb][nb][i] * rstd, 0.f); u[nb] = v * v; }
                u32x2 ov; ov.x = pk2(u[0], u[1]); ov.y = pk2(u[2], u[3]);
                __builtin_nontemporal_store(ov, (u32x2*)(U + row * 4096 + col));
            }
        ++rtpar;
    }
    {
        float* red = (float*)lds; float* c1 = (float*)(lds + 32768); const float* SSQS = (const float*)(P.ws + WS_SSQS);
#pragma unroll 1
        for (int pc = blockIdx.x; pc < 8 * 128; pc += gridDim.x) {
            const int rg = pc >> 7, cg = pc & 127;
            small_tile(A2, 1024, MPR + 32 * rg, W, 1024, 32 * cg, 1024, c1, red);
            const int rl = t >> 4, cl = (t & 15) * 2; const int srow = 32 * rg + rl, col = 32 * cg + cl;
            float ss = 0.f;
#pragma unroll
            for (int j = 0; j < 8; ++j) { const f32x4 sv = *(const f32x4*)(SSQS + srow * 32 + 4 * j); ss += (sv.x + sv.y) + (sv.z + sv.w); }
            const float rstd = frsq(ss * (1.f / 1024.f) + EPS);
            const float u0 = fmaxf(c1[rl * 33 + cl] * rstd, 0.f), u1 = fmaxf(c1[rl * 33 + cl + 1] * rstd, 0.f);
            __builtin_nontemporal_store(pk2(u0 * u0, u1 * u1), (unsigned*)(U + (size_t)(MPR + srow) * 4096 + col));
            __syncthreads();
        }
    }
}

DI void phase_p7(const Params& P, unsigned char* lds) {
    const bf16_t* U = (const bf16_t*)(P.ws + WS_U); const bf16_t* W = (const bf16_t*)(P.ws + WS_WFF2);
    const int t = opaque_tid(), w = t >> 6, lane = t & 63, r = lane & 31, hh = lane >> 5, wm = w >> 1, wn = w & 1;
    constexpr int NTN = 4;
    bool pre = false;
#pragma unroll 1
    for (int tile = blockIdx.x; tile < 128 * NTN; tile += gridDim.x) {
        const int mt = tile / NTN, nt = tile % NTN; const int m0 = (mt >> 5) * LP + OFF + (mt & 31) * 256, n0 = nt * 256;
        f32x16 acc[2][4];
#pragma unroll
        for (int a = 0; a < 2; ++a)
#pragma unroll
            for (int b = 0; b < 4; ++b) acc[a][b] = zero16();
        gemm_mainloop<4>(acc, U, 4096, m0, W, 4096, n0, 4096, lds, pre);
        { const int tn = tile + gridDim.x; pre = tn < 128 * NTN; if (pre) { const int mtn = tn / NTN, ntn_ = tn % NTN; f32x16 (&dummy)[2][4] = acc; gemm_mainloop<4>(dummy, U, 4096, (mtn >> 5) * LP + OFF + (mtn & 31) * 256, W, 4096, ntn_ * 256, 4096, lds, false, true); } }
        const int col = n0 + wn * 128 + 4 * r;
        const size_t crow0 = (size_t)mt * 256 + wm * 64 + 4 * hh;
#pragma unroll
        for (int mb = 0; mb < 2; ++mb) {
#pragma unroll
          for (int hf = 0; hf < 2; ++hf) {
            f32x4 yv[16];
#pragma unroll
            for (int i = 8 * hf; i < 8 * hf + 8; ++i) yv[i] = *(const f32x4*)(P.out + O_Y + (crow0 + mb * 32 + (i & 3) + 8 * (i >> 2)) * 1024 + col);
#pragma unroll
            for (int i = 8 * hf; i < 8 * hf + 8; ++i) {
                f32x4 o = yv[i]; o.x += acc[mb][0][i]; o.y += acc[mb][1][i]; o.z += acc[mb][2][i]; o.w += acc[mb][3][i];
                __builtin_nontemporal_store(o, (f32x4*)(P.out + O_Y + (crow0 + mb * 32 + (i & 3) + 8 * (i >> 2)) * 1024 + col));
            }
          }
        }
    }
    {
        float* red = (float*)lds; float* c1 = (float*)(lds + 32768);
#pragma unroll 1
        for (int pc = blockIdx.x; pc < 8 * 32; pc += gridDim.x) {
            const int rg = pc >> 5, cg = pc & 31;
            small_tile(U, 4096, MPR + 32 * rg, W, 4096, 32 * cg, 4096, c1, red);
            const int rl = t >> 4, cl = (t & 15) * 2; const int srow = 32 * rg + rl, col = 32 * cg + cl;
            f32x2* yp = (f32x2*)(P.out + O_YS + (size_t)srow * 1024 + col);
            f32x2 yv = *yp; yv.x += c1[rl * 33 + cl]; yv.y += c1[rl * 33 + cl + 1]; *yp = yv;
            __syncthreads();
        }
    }
}

template <bool OUT>
DI void ret_chunk(const Params& P, unsigned char* lds, f32x16 (&S)[4], size_t row0, int CL, int head, float lg2_in) {
    float lg2 = lg2_in; asm volatile("" : "+v"(lg2));
    const int t = opaque_tid(), w = t >> 6, lane = t & 63, r = lane & 31, hh = lane >> 5;
    const bf16_t* RQ = (const bf16_t*)(P.ws + WS_RQ); const bf16_t* RK = (const bf16_t*)(P.ws + WS_RK); const bf16_t* RV = (const bf16_t*)(P.ws + WS_RV);
    bf16_t* RG = (bf16_t*)(P.ws + WS_RG);
    unsigned char* Qs = lds; unsigned char* Ks = lds + 17408; unsigned char* KTs = lds + 34816; unsigned char* VTs = lds + 53248; float* OUTs = (float*)(lds + 90112);
    {
        const int n = t & 63; const bool live = n < CL;
        const float kdec = ex2((float)(CL - 1 - n) * lg2);
#pragma unroll
        for (int i = 0; i < 2; ++i) {
            const int dc = (t >> 6) + 8 * i;
            u32x4 kv = (u32x4){0u, 0u, 0u, 0u};
            if (live) kv = *(const u32x4*)(RK + (row0 + n) * 512 + head * 128 + dc * 8);
            if (OUT) {
                u32x4 qv = (u32x4){0u, 0u, 0u, 0u};
                if (live) qv = *(const u32x4*)(RQ + (row0 + n) * 512 + head * 128 + dc * 8);
                *(u32x4*)(Qs + n * 272 + dc * 16) = qv; *(u32x4*)(Ks + n * 272 + dc * 16) = kv;
            }
#pragma unroll
            for (int e = 0; e < 4; ++e) {
                const unsigned u = kv[e];
                *(bf16_t*)(KTs + (dc * 8 + 2 * e) * 144 + n * 2) = f2bf(bflo(u) * kdec);
                *(bf16_t*)(KTs + (dc * 8 + 2 * e + 1) * 144 + n * 2) = f2bf(bfhi(u) * kdec);
            }
        }
#pragma unroll
        for (int i = 0; i < 4; ++i) {
            const int vc = (t >> 6) + 8 * i;
            u32x4 vv = (u32x4){0u, 0u, 0u, 0u};
            if (live) vv = *(const u32x4*)(RV + (row0 + n) * 1024 + head * 256 + vc * 8);
#pragma unroll
            for (int e = 0; e < 4; ++e) {
                const unsigned u = vv[e];
                *(bf16_t*)(VTs + (vc * 8 + 2 * e) * 144 + n * 2) = (bf16_t)(u & 0xffffu);
                *(bf16_t*)(VTs + (vc * 8 + 2 * e + 1) * 144 + n * 2) = (bf16_t)(u >> 16);
            }
        }
    }
    __syncthreads();
    __builtin_amdgcn_sched_barrier(0);
    if (OUT) {
        f32x16 o[2]; o[0] = zero16(); o[1] = zero16();
#pragma unroll
        for (int db = 0; db < 4; ++db)
#pragma unroll
            for (int sp = 0; sp < 2; ++sp) {
                const bf16x8 bs = pack8(S[db], sp);
#pragma unroll
                for (int nbo = 0; nbo < 2; ++nbo) {
                    const unsigned char* qa = Qs + (32 * nbo + r) * 272 + (32 * db + 16 * sp + 4 * hh) * 2;
                    const bf16x8 a = cat4(*(const s16x4*)qa, *(const s16x4*)(qa + 16));
                    o[nbo] = MFMA(a, bs, o[nbo]);
                }
            }
        __builtin_amdgcn_sched_barrier(0);
#pragma unroll
        for (int nbo = 0; nbo < 2; ++nbo)
#pragma unroll
            for (int i = 0; i < 16; ++i) o[nbo][i] *= ex2((float)(32 * nbo + crow(i, hh) + 1) * lg2);
        __builtin_amdgcn_sched_barrier(0);
#pragma unroll
        for (int tix = 0; tix < 3; ++tix) {
            const int mb = (tix == 2) ? 1 : 0, nb = (tix == 0) ? 0 : 1;
            __builtin_amdgcn_sched_barrier(0);
            f32x16 x = zero16();
#pragma unroll
            for (int s = 0; s < 8; ++s) {
                const bf16x8 a = *(const bf16x8*)(Ks + (32 * mb + r) * 272 + (16 * s + 8 * hh) * 2);
                const bf16x8 b = *(const bf16x8*)(Qs + (32 * nb + r) * 272 + (16 * s + 8 * hh) * 2);
                x = MFMA(a, b, x);
            }
#pragma unroll
            for (int i = 0; i < 16; ++i) {
                const int d = (32 * nb + r) - (32 * mb + crow(i, hh));
                x[i] = (d >= 0) ? x[i] * ex2((float)d * lg2) : 0.f;
            }
#pragma unroll
            for (int sp = 0; sp < 2; ++sp) {
                const bf16x8 xa = pack8(x, sp);
                const unsigned char* va = VTs + (32 * w + r) * 144 + (32 * mb + 16 * sp + 4 * hh) * 2;
                const bf16x8 b = cat4(*(const s16x4*)va, *(const s16x4*)(va + 16));
                o[nb] = MFMA(xa, b, o[nb]);
            }
        }
        __builtin_amdgcn_sched_barrier(0);
#pragma unroll
        for (int nb = 0; nb < 2; ++nb)
#pragma unroll
            for (int i = 0; i < 16; ++i) OUTs[(32 * nb + crow(i, hh)) * 260 + 32 * w + r] = o[nb][i];
        __builtin_amdgcn_sched_barrier(0);
    }
    {
        const float gC = ex2((float)CL * lg2);
#pragma unroll
        for (int db = 0; db < 4; ++db) S[db] = S[db] * gC;
#pragma unroll
        for (int s = 0; s < 4; ++s) {
            const bf16x8 b = *(const bf16x8*)(VTs + (32 * w + r) * 144 + (16 * s + 8 * hh) * 2);
#pragma unroll
            for (int db = 0; db < 4; ++db) {
                const bf16x8 a = *(const bf16x8*)(KTs + (32 * db + r) * 144 + (16 * s + 8 * hh) * 2);
                S[db] = MFMA(a, b, S[db]);
            }
        }
    }
    __syncthreads();
    __builtin_amdgcn_sched_barrier(0);
    if (OUT) {
        const int n = t >> 3, sg = t & 7;
        f32x4 xv[8]; float s1 = 0.f, s2 = 0.f;
#pragma unroll
        for (int j = 0; j < 8; ++j) {
            xv[j] = *(const f32x4*)(OUTs + n * 260 + sg * 32 + 4 * j);
            s1 += (xv[j].x + xv[j].y) + (xv[j].z + xv[j].w);
            s2 += (xv[j].x * xv[j].x + xv[j].y * xv[j].y) + (xv[j].z * xv[j].z + xv[j].w * xv[j].w);
        }
#pragma unroll
        for (int o = 1; o < 8; o <<= 1) { s1 += __shfl_xor(s1, o); s2 += __shfl_xor(s2, o); }
        const float mean = s1 * (1.f / 256.f); const float var = fmaxf(s2 * (1.f / 256.f) - mean * mean, 0.f);
        const float rstd = frsq(var + EPS);
        if (n < CL) {
            bf16_t* gp = RG + (row0 + n) * 1024 + head * 256 + sg * 32;
            const float* gn = P.ret_gn_g + head * 256 + sg * 32;
            u32x4 gu[4];
#pragma unroll
            for (int j = 0; j < 4; ++j) gu[j] = *(const u32x4*)(gp + 8 * j);
#pragma unroll
            for (int j = 0; j < 4; ++j) {
                const f32x4 g0 = *(const f32x4*)(gn + 8 * j), g1 = *(const f32x4*)(gn + 8 * j + 4);
                const f32x4 xa = xv[2 * j], xb = xv[2 * j + 1];
                float y[8], gt[8];
                gt[0] = bflo(gu[j].x); gt[1] = bfhi(gu[j].x); gt[2] = bflo(gu[j].y); gt[3] = bfhi(gu[j].y); gt[4] = bflo(gu[j].z); gt[5] = bfhi(gu[j].z); gt[6] = bflo(gu[j].w); gt[7] = bfhi(gu[j].w);
                y[0] = (xa.x - mean) * rstd * g0.x; y[1] = (xa.y - mean) * rstd * g0.y; y[2] = (xa.z - mean) * rstd * g0.z; y[3] = (xa.w - mean) * rstd * g0.w;
                y[4] = (xb.x - mean) * rstd * g1.x; y[5] = (xb.y - mean) * rstd * g1.y; y[6] = (xb.z - mean) * rstd * g1.z; y[7] = (xb.w - mean) * rstd * g1.w;
#pragma unroll
                for (int e = 0; e < 8; ++e) y[e] *= gt[e] * frcp(1.f + ex2(-LOG2E * gt[e]));
                u32x4 ou; ou.x = pk2(y[0], y[1]); ou.y = pk2(y[2], y[3]); ou.z = pk2(y[4], y[5]); ou.w = pk2(y[6], y[7]);
                *(u32x4*)(gp + 8 * j) = ou;
            }
        }
    }
}

DI float head_lg2(int head) { return log2f(1.f - 1.f / (float)(32 << head)); }

DI void ret_passA_item(const Params& P, unsigned char* lds, int item) {
    const int bh = item / 12, g = item % 12, b = bh >> 2, head = bh & 3;
    const int t = opaque_tid(), w = t >> 6, lane = t & 63;
    const float lg2 = head_lg2(head);
    f32x16 S[4];
#pragma unroll
    for (int db = 0; db < 4; ++db) S[db] = zero16();
#pragma unroll 1
    for (int c = 0; c < 10; ++c) ret_chunk<false>(P, lds, S, (size_t)b * LP + 640 * g + 64 * c, 64, head, lg2);
    float* T = (float*)(P.ws + WS_TG) + ((size_t)item * 8 + w) * 4096;
#pragma unroll
    for (int db = 0; db < 4; ++db)
#pragma unroll
        for (int i = 0; i < 16; ++i) T[(db * 16 + i) * 64 + lane] = S[db][i];
}

DI void ret_passC_prompt(const Params& P, unsigned char* lds, int bh, int g) {
    const int b = bh >> 2, head = bh & 3;
    const int t = opaque_tid(), w = t >> 6, lane = t & 63, r = lane & 31, hh = lane >> 5;
    const float lg2 = head_lg2(head);
    f32x16 S[4];
#pragma unroll
    for (int db = 0; db < 4; ++db) S[db] = zero16();
    const float g640 = ex2(640.f * lg2);
#pragma unroll 1
    for (int gp = 0; gp < g; ++gp) {
        const float* T = (const float*)(P.ws + WS_TG) + ((size_t)(bh * 12 + gp) * 8 + w) * 4096;
#pragma unroll
        for (int db = 0; db < 4; ++db)
#pragma unroll
            for (int i = 0; i < 16; ++i) S[db][i] = S[db][i] * g640 + T[(db * 16 + i) * 64 + lane];
    }
#pragma unroll 1
    for (int c = 0; c < 10; ++c) ret_chunk<true>(P, lds, S, (size_t)b * LP + 640 * g + 64 * c, 64, head, lg2);
    if (g == 12) {
        float* dst = P.out + O_PST + (size_t)bh * 32768;
#pragma unroll
        for (int db = 0; db < 4; ++db)
#pragma unroll
            for (int i = 0; i < 16; ++i) dst[(32 * db + crow(i, hh)) * 256 + 32 * w + r] = S[db][i];
    }
    __syncthreads();
}

DI void ret_sample_item(const Params& P, unsigned char* lds, int sb, int head) {
    const int t = opaque_tid(), w = t >> 6, lane = t & 63, r = lane & 31, hh = lane >> 5;
    const float lg2 = head_lg2(head);
    const float* src = P.state_ret + (size_t)(sb * 4 + head) * 32768;
    f32x16 S[4];
#pragma unroll
    for (int db = 0; db < 4; ++db)
#pragma unroll
        for (int i = 0; i < 16; ++i) S[db][i] = src[(32 * db + crow(i, hh)) * 256 + 32 * w + r];
    ret_chunk<true>(P, lds, S, (size_t)MPR + sb * 32, 32, head, lg2);
    float* dst = P.out + O_SST + (size_t)(sb * 4 + head) * 32768;
#pragma unroll
    for (int db = 0; db < 4; ++db)
#pragma unroll
        for (int i = 0; i < 16; ++i) dst[(32 * db + crow(i, hh)) * 256 + 32 * w + r] = S[db][i];
    __syncthreads();
}

DI double wave_incl_scan(double v, int lane) {
#pragma unroll
    for (int o = 1; o < 64; o <<= 1) { const double u = __shfl_up(v, o); if (lane >= o) v += u; }
    return v;
}
DI void cumsum_seq(const Params& P, int seq, int lane) {
    if (seq < 32) {
        const int b = seq >> 3, h = seq & 7;
        const float* lf = (const float*)(P.ws + WS_LOGF) + (size_t)b * LP * 8 + h;
        float* nck = (float*)(P.ws + WS_NCKP) + (size_t)seq * LP;
        double loc = 0.0;
#pragma unroll 1
        for (int bt = 0; bt < 5; ++bt) {
            float v[26];
#pragma unroll
            for (int j = 0; j < 26; ++j) v[j] = lf[(size_t)(130 * lane + 26 * bt + j) * 8];
#pragma unroll
            for (int j = 0; j < 26; ++j) loc += (double)v[j];
        }
        const double inc = wave_incl_scan(loc, lane);
        double run = inc - loc;
#pragma unroll 1
        for (int bt = 0; bt < 5; ++bt) {
            float v[26];
#pragma unroll
            for (int j = 0; j < 26; ++j) v[j] = lf[(size_t)(130 * lane + 26 * bt + j) * 8];
#pragma unroll
            for (int j = 0; j < 26; ++j) { const int p = 130 * lane + 26 * bt + j; run += (double)v[j]; nck[p] = (p < VAL0) ? -1e30f : -(float)run; }
        }
    } else {
        const int s = seq - 32, sb = s >> 3, h = s & 7;
        const float* cl = P.cache_logf + (size_t)sb * 4096 * 8 + h;
        float* nck = (float*)(P.ws + WS_NCKS) + (size_t)s * 4128;
        double loc = 0.0;
#pragma unroll 1
        for (int bt = 0; bt < 4; ++bt) {
            float v[16];
#pragma unroll
            for (int j = 0; j < 16; ++j) v[j] = cl[(size_t)(64 * lane + 16 * bt + j) * 8];
#pragma unroll
            for (int j = 0; j < 16; ++j) loc += (double)v[j];
        }
        const double inc = wave_incl_scan(loc, lane);
        double run = inc - loc;
#pragma unroll 1
        for (int bt = 0; bt < 4; ++bt) {
            float v[16];
#pragma unroll
            for (int j = 0; j < 16; ++j) v[j] = cl[(size_t)(64 * lane + 16 * bt + j) * 8];
#pragma unroll
            for (int j = 0; j < 16; ++j) { const int p = 64 * lane + 16 * bt + j; run += (double)v[j]; nck[p] = -(float)run; }
        }
        const double tot = __shfl(inc, 63);
        const float* lf = (const float*)(P.ws + WS_LOGF) + ((size_t)MPR + sb * 32) * 8 + h;
        const double mine = (lane < 32) ? (double)lf[(size_t)lane * 8] : 0.0;
        const double inc2 = wave_incl_scan(mine, lane);
        if (lane < 32) nck[4096 + lane] = -(float)(tot + inc2);
    }
}

DI void phase_p2(const Params& P, unsigned char* lds) {
    constexpr int NRET = 192, NCUM = 12;
    for (int it = blockIdx.x; it < NRET + NCUM; it += gridDim.x) {
        if (it < NRET) { ret_passA_item(P, lds, it); __syncthreads(); }
        else { const int seq = (it - NRET) * 8 + (threadIdx.x >> 6); cumsum_seq(P, seq, threadIdx.x & 63); }
    }
}

DI void attn_prompt_item(const Params& P, unsigned char* lds, int b, int head, int qb, float qkb2) {
    const int t = opaque_tid(), w = t >> 6, lane = t & 63, r = lane & 31, hh = lane >> 5;
    const bf16_t* FK = (const bf16_t*)(P.ws + WS_FK); const bf16_t* VT = (const bf16_t*)(P.ws + WS_VT); bf16_t* FQ = (bf16_t*)(P.ws + WS_FQ);
    const float* NCK = (const float*)(P.ws + WS_NCKP) + (size_t)(b * 8 + head) * LP;
    const int q0 = OFF + 256 * qb, qw0 = q0 + 32 * w, myq = qw0 + r;
    const float cref = -NCK[q0];
    bf16_t* qp = FQ + ((size_t)b * LP + myq) * 1024 + head * 128;
    bf16x8 qf[8];
#pragma unroll
    for (int s = 0; s < 8; ++s) qf[s] = *(const bf16x8*)(qp + 16 * s + 8 * hh);
    f32x16 o[4];
#pragma unroll
    for (int db = 0; db < 4; ++db) o[db] = zero16();
    float m_run = -1e30f, l_run = 0.f;
    const int kt_last = (q0 + 255) >> 6;
    constexpr int BUF = 36864, VOFF = 17408, BOFF = 35840, WMOFF = 3 * BUF;
    const int kkey = t >> 4, kdc = t & 15;
    const int vd = t >> 3, vkc = t & 7;
    const bf16_t* kg = FK + ((size_t)b * LP + kkey) * 1024 + head * 128 + kdc * 8;
    const bf16_t* vg = VT + ((size_t)((b * 8 + head) * 128 + vd)) * LP + vkc * 8;
    u32x4 kr[2], vr[2]; float br = 0.f;
#define ATT_GLOAD(KT) do { const int kbase_ = (KT) * 64; \
        kr[0] = *(const u32x4*)(kg + (size_t)kbase_ * 1024); kr[1] = *(const u32x4*)(kg + (size_t)(kbase_ + 32) * 1024); \
        vr[0] = *(const u32x4*)(vg + kbase_); vr[1] = *(const u32x4*)(vg + (size_t)64 * LP + kbase_); \
        if (t < 64) br = (NCK[kbase_ + t] + cref) * LOG2E; } while (0)
#define ATT_SWRITE(BI) do { unsigned char* sb_ = lds + (BI) * BUF; \
        *(u32x4*)(sb_ + kkey * 272 + kdc * 16) = kr[0]; *(u32x4*)(sb_ + (kkey + 32) * 272 + kdc * 16) = kr[1]; \
        *(u32x4*)(sb_ + VOFF + vd * 144 + vkc * 16) = vr[0]; *(u32x4*)(sb_ + VOFF + (vd + 64) * 144 + vkc * 16) = vr[1]; \
        if (t < 64) *(float*)(sb_ + BOFF + t * 4) = br; } while (0)
#define ATT_PV(SBV, PP) do { _Pragma("unroll") for (int kb_ = 0; kb_ < 2; ++kb_) _Pragma("unroll") for (int sp_ = 0; sp_ < 2; ++sp_) _Pragma("unroll") for (int db_ = 0; db_ < 4; ++db_) { \
        const unsigned char* va_ = (SBV) + VOFF + (32 * db_ + r) * 144 + (32 * kb_ + 16 * sp_ + 4 * hh) * 2; \
        o[db_] = MFMA(cat4(*(const s16x4*)va_, *(const s16x4*)(va_ + 16)), PP[kb_][sp_], o[db_]); } } while (0)
    float* WM = (float*)(lds + WMOFF);
    if (t < 16) WM[t] = -1e30f;
    ATT_GLOAD(kt_last); ATT_SWRITE(kt_last % 3);
    __syncthreads();
    const bool late = __builtin_amdgcn_readfirstlane(w) >= 4;
    bf16x8 pp[2][2]; bool pending = false; int pbuf = 0;
#pragma unroll 1
    for (int kt = kt_last; kt >= 1; --kt) {
        const int bi = kt % 3;
        const unsigned char* sb = lds + bi * BUF;
        {
            const f32x4 w0 = *(const f32x4*)(WM + ((kt + 1) & 1) * 8), w1 = *(const f32x4*)(WM + ((kt + 1) & 1) * 8 + 4);
            const float mfloor = fminf(fminf(fminf(w0.x, w0.y), fminf(w0.z, w0.w)), fminf(fminf(w1.x, w1.y), fminf(w1.z, w1.w)));
            const float blast = *(const float*)(sb + BOFF + 63 * 4);
            if (blast + qkb2 < mfloor - 32.f) break;
        }
        const bool more = kt > 1;
        if (more) ATT_GLOAD(kt - 1);
        if (pending) { ATT_PV(lds + pbuf * BUF, pp); pending = false; }
        float wmin = -1e30f;
        if (kt * 64 <= qw0 + 31) {
            f32x16 st[2];
#pragma unroll
            for (int kb = 0; kb < 2; ++kb) {
                st[kb] = zero16();
#pragma unroll
                for (int s = 0; s < 8; ++s) {
                    const bf16x8 a = *(const bf16x8*)(sb + (32 * kb + r) * 272 + (16 * s + 8 * hh) * 2);
                    st[kb] = MFMA(a, qf[s], st[kb]);
                }
            }
            const bool need_mask = (kt * 64 + 63 > qw0);
            float mx = -1e30f;
#pragma unroll
            for (int kb = 0; kb < 2; ++kb)
#pragma unroll
                for (int g = 0; g < 4; ++g) {
                    const f32x4 bz = *(const f32x4*)(sb + BOFF + (32 * kb + 8 * g + 4 * hh) * 4);
#pragma unroll
                    for (int e = 0; e < 4; ++e) {
                        float v = st[kb][4 * g + e] * ATT_SC + bz[e];
                        if (need_mask) { const int key = kt * 64 + 32 * kb + 8 * g + 4 * hh + e; v = (key > myq) ? -1e30f : v; }
                        st[kb][4 * g + e] = v; mx = fmaxf(mx, v);
                    }
                }
            mx = fmaxf(mx, __shfl_xor(mx, 32));
            const float m_new = fmaxf(m_run, mx);
            const bool grew = __builtin_amdgcn_ballot_w64(m_new > m_run) != 0ull;
            float ps = 0.f;
#pragma unroll
            for (int kb = 0; kb < 2; ++kb)
#pragma unroll
                for (int i = 0; i < 16; ++i) { const float pv = ex2(st[kb][i] - m_new); st[kb][i] = pv; ps += pv; }
            if (grew) {
                const float alpha = ex2(m_run - m_new); m_run = m_new;
                l_run = l_run * alpha;
#pragma unroll
                for (int db = 0; db < 4; ++db) o[db] = o[db] * alpha;
            }
            l_run += ps;
#pragma unroll
            for (int kb = 0; kb < 2; ++kb)
#pragma unroll
                for (int sp = 0; sp < 2; ++sp) pp[kb][sp] = pack8(st[kb], sp);
            if (late) { pending = true; pbuf = bi; }
            else ATT_PV(sb, pp);
            wmin = m_run;
#pragma unroll
            for (int of = 1; of < 32; of <<= 1) wmin = fminf(wmin, __shfl_xor(wmin, of));
        }
        if (lane == 0) WM[(kt & 1) * 8 + w] = wmin;
        if (more) ATT_SWRITE((kt - 1) % 3);
        __syncthreads();
    }
    if (pending) ATT_PV(lds + pbuf * BUF, pp);
#undef ATT_GLOAD
#undef ATT_SWRITE
#undef ATT_PV
    const float lt = l_run + __shfl_xor(l_run, 32);
    const float inv = frcp(lt);
#pragma unroll
    for (int db = 0; db < 4; ++db)
#pragma unroll
        for (int g = 0; g < 4; ++g) {
            u32x2 ov; ov.x = pk2(o[db][4 * g] * inv, o[db][4 * g + 1] * inv); ov.y = pk2(o[db][4 * g + 2] * inv, o[db][4 * g + 3] * inv);
            *(u32x2*)(qp + 32 * db + 8 * g + 4 * hh) = ov;
        }
}

DI void attn_sample_item(const Params& P, unsigned char* lds, int sb, int head) {
    const int t = opaque_tid(), w = t >> 6, lane = t & 63, r = lane & 31, hh = lane >> 5;
    bf16_t* FQ = (bf16_t*)(P.ws + WS_FQ);
    const float* NCK = (const float*)(P.ws + WS_NCKS) + (size_t)(sb * 8 + head) * 4128;
    const float cref = -NCK[4096];
    bf16_t* qrow = FQ + ((size_t)MPR + sb * 32) * 1024 + head * 128;
    bf16x8 qf[8];
#pragma unroll
    for (int s = 0; s < 8; ++s) qf[s] = *(const bf16x8*)(qrow + (size_t)r * 1024 + 16 * s + 8 * hh);
    f32x16 o[4];
#pragma unroll
    for (int db = 0; db < 4; ++db) o[db] = zero16();
    float m_run = -1e30f, l_run = 0.f;
#pragma unroll 1
    for (int tile = w; tile < 129; tile += 8) {
        const float *kbase, *vbase;
        if (tile < 128) { const size_t off = ((size_t)sb * 4096 + 32 * tile) * 1024 + head * 128; kbase = P.cache_k + off; vbase = P.cache_v + off; }
        else { const size_t off = (size_t)sb * 32 * 1024 + head * 128; kbase = P.out + O_SK + off; vbase = P.out + O_SV + off; }
        f32x16 st = zero16();
#pragma unroll
        for (int s = 0; s < 8; ++s) {
            const float* kp = kbase + (size_t)r * 1024 + 16 * s + 8 * hh;
            const f32x4 k0 = *(const f32x4*)kp, k1 = *(const f32x4*)(kp + 4);
            u32x4 pk; pk.x = pk2(k0.x, k0.y); pk.y = pk2(k0.z, k0.w); pk.z = pk2(k1.x, k1.y); pk.w = pk2(k1.z, k1.w);
            st = MFMA(__builtin_bit_cast(bf16x8, pk), qf[s], st);
        }
        float mx = -1e30f;
#pragma unroll
        for (int g = 0; g < 4; ++g) {
            const f32x4 bz = *(const f32x4*)(NCK + 32 * tile + 8 * g + 4 * hh);
#pragma unroll
            for (int e = 0; e < 4; ++e) {
                float v = st[4 * g + e] * ATT_SC + (bz[e] + cref) * LOG2E;
                if (tile == 128) { const int key = 8 * g + 4 * hh + e; v = (key > r) ? -1e30f : v; }
                st[4 * g + e] = v; mx = fmaxf(mx, v);
            }
        }
        mx = fmaxf(mx, __shfl_xor(mx, 32));
        const float m_new = fmaxf(m_run, mx);
        const float alpha = ex2(m_run - m_new); m_run = m_new;
        float ps = 0.f;
#pragma unroll
        for (int i = 0; i < 16; ++i) { const float pv = ex2(st[i] - m_new); st[i] = pv; ps += pv; }
        l_run = l_run * alpha + ps;
#pragma unroll
        for (int db = 0; db < 4; ++db) o[db] = o[db] * alpha;
#pragma unroll
        for (int sp = 0; sp < 2; ++sp) {
            const bf16x8 pb = pack8(st, sp);
#pragma unroll
            for (int db = 0; db < 4; ++db) {
                const float* vp = vbase + (size_t)(16 * sp + 4 * hh) * 1024 + 32 * db + r;
                float f[8];
#pragma unroll
                for (int j = 0; j < 8; ++j) f[j] = vp[(size_t)((j & 3) + 8 * (j >> 2)) * 1024];
                u32x4 pk; pk.x = pk2(f[0], f[1]); pk.y = pk2(f[2], f[3]); pk.z = pk2(f[4], f[5]); pk.w = pk2(f[6], f[7]);
                o[db] = MFMA(__builtin_bit_cast(bf16x8, pk), pb, o[db]);
            }
        }
    }
    const float lt = l_run + __shfl_xor(l_run, 32);
    float* Ol = (float*)lds; float* ML = (float*)(lds + 131072);
#pragma unroll
    for (int db = 0; db < 4; ++db)
#pragma unroll
        for (int i = 0; i < 16; ++i) Ol[(w * 128 + 32 * db + crow(i, hh)) * 32 + r] = o[db][i];
    if (hh == 0) { ML[(w * 32 + r) * 2] = m_run; ML[(w * 32 + r) * 2 + 1] = lt; }
    __syncthreads();
    {
        const int q = t & 31, dg = t >> 5;
        float M = -1e30f;
#pragma unroll
        for (int ww = 0; ww < 8; ++ww) M = fmaxf(M, ML[(ww * 32 + q) * 2]);
        float L = 0.f, a[8];
#pragma unroll
        for (int e = 0; e < 8; ++e) a[e] = 0.f;
#pragma unroll
        for (int ww = 0; ww < 8; ++ww) {
            const float f = ex2(ML[(ww * 32 + q) * 2] - M); L += ML[(ww * 32 + q) * 2 + 1] * f;
#pragma unroll
            for (int e = 0; e < 8; ++e) a[e] += Ol[(ww * 128 + dg * 8 + e) * 32 + q] * f;
        }
        const float inv = frcp(L);
        u32x4 ov; ov.x = pk2(a[0] * inv, a[1] * inv); ov.y = pk2(a[2] * inv, a[3] * inv); ov.z = pk2(a[4] * inv, a[5] * inv); ov.w = pk2(a[6] * inv, a[7] * inv);
        *(u32x4*)(qrow + (size_t)q * 1024 + dg * 8) = ov;
    }
    __syncthreads();
}

DI void phase_p3(const Params& P, unsigned char* lds) {
    constexpr int N_RETP = 208, N_RETS = 32, N_AS = 64, N_AP = 1024;
    constexpr int NITEMS = N_RETP + N_RETS + N_AS + N_AP;
    int* s_item = (int*)(lds + LDS_BYTES - 16);
    unsigned* ctr = (unsigned*)(P.ws + WS_CTL);
    float qkb2;
    {
        const int lane = threadIdx.x & 63;
        float gq = fmaxf(fabsf(P.q_norm_g[lane]), fabsf(P.q_norm_g[lane + 64])), gk = fmaxf(fabsf(P.k_norm_g[lane]), fabsf(P.k_norm_g[lane + 64]));
#pragma unroll
        for (int o = 1; o < 64; o <<= 1) { gq = fmaxf(gq, __shfl_xor(gq, o)); gk = fmaxf(gk, __shfl_xor(gk, o)); }
        qkb2 = 128.f * gq * gk * 1.02f * ATT_SC;
    }
    for (;;) {
        if (threadIdx.x == 0) *s_item = (int)atomicAdd(ctr, 1u);
        __syncthreads();
        int it = *s_item;
        __syncthreads();
        if (it >= NITEMS) break;
        if (it < 256) { const int head = 7 - (it >> 7), rem = it & 127; attn_prompt_item(P, lds, rem & 3, head, 31 - (rem >> 2), qkb2); continue; } it -= 256;
        if (it < N_RETP) { ret_passC_prompt(P, lds, it / 13, it % 13); continue; } it -= N_RETP;
        if (it < N_RETS) { ret_sample_item(P, lds, it >> 2, it & 3); continue; } it -= N_RETS;
        if (it < N_AS) { attn_sample_item(P, lds, it >> 3, it & 7); continue; } it -= N_AS;
        { const int head = 5 - (it >> 7), rem = it & 127; attn_prompt_item(P, lds, rem & 3, head, 31 - (rem >> 2), qkb2); }
    }
}

DI void light_grid_barrier(unsigned* ctl, unsigned seam) {
    asm volatile("s_waitcnt vmcnt(0)" ::: "memory");
    __syncthreads();
    if (threadIdx.x == 0) {
        const unsigned g = blockIdx.x & 7u, gs = (gridDim.x - g + 7u) >> 3, ng = gridDim.x < 8u ? gridDim.x : 8u;
        __builtin_amdgcn_fence(__ATOMIC_RELEASE, "agent");
        asm volatile("s_waitcnt vmcnt(0)" ::: "memory");
        const unsigned old = __hip_atomic_fetch_add(ctl + 64 + 32 * g, 1u, __ATOMIC_RELAXED, __HIP_MEMORY_SCOPE_AGENT);
        if (old == seam * gs + gs - 1u) {
            __builtin_amdgcn_fence(__ATOMIC_ACQ_REL, "agent");
            asm volatile("s_waitcnt vmcnt(0)" ::: "memory");
            const unsigned oldt = __hip_atomic_fetch_add(ctl + 32, 1u, __ATOMIC_RELAXED, __HIP_MEMORY_SCOPE_AGENT);
            if (oldt == seam * ng + ng - 1u) {
                __builtin_amdgcn_fence(__ATOMIC_ACQ_REL, "agent");
                asm volatile("s_waitcnt vmcnt(0)" ::: "memory");
                for (unsigned j = 0; j < ng; ++j) __hip_atomic_store(ctl + 320 + 32 * j, seam + 1u, __ATOMIC_RELAXED, __HIP_MEMORY_SCOPE_AGENT);
            }
        }
        while (__hip_atomic_load(ctl + 320 + 32 * g, __ATOMIC_RELAXED, __HIP_MEMORY_SCOPE_AGENT) < seam + 1u) __builtin_amdgcn_s_sleep(8);
        __builtin_amdgcn_fence(__ATOMIC_ACQUIRE, "agent");
        asm volatile("s_waitcnt vmcnt(0)" ::: "memory");
    }
    __syncthreads();
}

__global__ void __launch_bounds__(512) mega_fwd(Params P) {
    extern __shared__ __attribute__((aligned(16))) unsigned char lds[];
    cg::grid_group grid = cg::this_grid();
#define RUN_PHASE(K, BODY) do { if (P.ph_lo <= (K) && (K) < P.ph_hi) { BODY; if (P.coop && (K) + 1 < P.ph_hi) { if (P.pad) grid.sync();     light_grid_barrier((unsigned*)(P.ws + WS_CTL), (unsigned)(K)); } } } while (0)
    RUN_PHASE(0, (p0_rows(P, lds), p0_weights(P, lds), p0_misc(P)));
    RUN_PHASE(1, phase_p1(P, lds));
    RUN_PHASE(2, phase_p2(P, lds));
    RUN_PHASE(3, phase_p3(P, lds));
    RUN_PHASE(4, phase_p4(P, lds));
    RUN_PHASE(5, phase_p5(P, lds));
    RUN_PHASE(6, phase_p6(P, lds));
    RUN_PHASE(7, phase_p7(P, lds));
#undef RUN_PHASE
}

extern "C" void kernel_launch(void* const* d_in, const int* in_sizes, int n_in, void* d_out, int out_size, void* d_ws, size_t ws_size, hipStream_t stream) {
    static int grid_blocks = 0;
    if (!grid_blocks) {
        int dev = 0, cus = 0, per_cu = 0;
        (void)hipGetDevice(&dev);
        (void)hipDeviceGetAttribute(&cus, hipDeviceAttributeMultiprocessorCount, dev);
        (void)hipFuncSetAttribute((const void*)mega_fwd, hipFuncAttributeMaxDynamicSharedMemorySize, LDS_BYTES);
        (void)hipOccupancyMaxActiveBlocksPerMultiprocessor(&per_cu, (const void*)mega_fwd, 512, LDS_BYTES);
        if (per_cu < 1) { fprintf(stderr, "kernel_launch: occupancy query returned %d\n", per_cu); per_cu = 1; }
        grid_blocks = cus * per_cu;
        if (ws_size < WS_END) fprintf(stderr, "kernel_launch: workspace too small: %zu < %zu\n", ws_size, (size_t)WS_END);
        (void)hipGetLastError();
    }
    Params p{};
    p.x_prompt = (const float*)d_in[0]; p.x_sample = (const float*)d_in[1]; p.state_ret = (const float*)d_in[2]; p.cache_k = (const float*)d_in[3];
    p.cache_v = (const float*)d_in[4]; p.cache_logf = (const float*)d_in[5]; p.meta = (const float*)d_in[6]; p.norm1_g = (const float*)d_in[7];
    p.w_in = (const float*)d_in[8]; p.b_forget = (const float*)d_in[9]; p.q_norm_g = (const float*)d_in[10]; p.k_norm_g = (const float*)d_in[11];
    p.ret_gn_g = (const float*)d_in[12]; p.w_ret_out = (const float*)d_in[13]; p.w_fox_out = (const float*)d_in[14]; p.w_o = (const float*)d_in[15];
    p.norm2_g = (const float*)d_in[16]; p.w_ff1 = (const float*)d_in[17]; p.w_ff2 = (const float*)d_in[18];
    p.out = (float*)d_out; p.ws = (unsigned char*)d_ws; p.pad = 0;
    (void)hipMemsetAsync((unsigned char*)d_ws + WS_CTL, 0, 4096, stream);
#if MULTI_LAUNCH
    for (int ph = 0; ph < 8; ++ph) {
        p.ph_lo = ph; p.ph_hi = ph + 1; p.coop = 0;
        hipLaunchKernelGGL(mega_fwd, dim3(grid_blocks), dim3(512), LDS_BYTES, stream, p);
    }
#else
    p.ph_lo = 0; p.ph_hi = 8; p.coop = 1;
    void* args[] = {&p};
    hipError_t e = hipLaunchCooperativeKernel((void*)mega_fwd, dim3(grid_blocks), dim3(512), args, LDS_BYTES, stream);
    if (e != hipSuccess) fprintf(stderr, "cooperative launch failed: %s (grid %d)\n", hipGetErrorString(e), grid_blocks);
#endif
}
```

```cpp
#include <hip/hip_runtime.h>
#include <hip/hip_cooperative_groups.h>
#include <cstdio>
#include <cstdint>
namespace cg = cooperative_groups;

#ifndef MULTI_LAUNCH
#define MULTI_LAUNCH 0
#endif

typedef short bf16x8 __attribute__((ext_vector_type(8)));
typedef short s16x4 __attribute__((ext_vector_type(4)));
typedef float f32x16 __attribute__((ext_vector_type(16)));
typedef float f32x4 __attribute__((ext_vector_type(4)));
typedef float f32x2 __attribute__((ext_vector_type(2)));
typedef unsigned u32x4 __attribute__((ext_vector_type(4)));
typedef unsigned u32x2 __attribute__((ext_vector_type(2)));
typedef __bf16 bf2_t __attribute__((ext_vector_type(2)));
typedef unsigned short bf16_t;
#define DI __device__ __forceinline__
#define MFMA(a, b, c) __builtin_amdgcn_mfma_f32_32x32x16_bf16((a), (b), (c), 0, 0, 0)

constexpr int D = 1024, LP = 8320, OFF = 128, VAL0 = 112, MPR = 33280, MT = 33536, INW = 8200, DFF = 4096;
constexpr int NTM = MT / 256;
constexpr float EPS = 1e-6f, LOG2E = 1.4426950408889634f;
constexpr float ATT_SC = 0.08838834764831845f * 1.4426950408889634f;
constexpr int LDS_BYTES = 163840;

constexpr size_t SZ_ACT = (size_t)MT * 1024 * 2;
constexpr size_t WS_CTL = 0;
constexpr size_t WS_XN = 4096;
constexpr size_t WS_WIN = WS_XN + SZ_ACT;
constexpr size_t WS_WRET = WS_WIN + (size_t)8192 * 1024 * 2;
constexpr size_t WS_WFOX = WS_WRET + 2097152;
constexpr size_t WS_WO = WS_WFOX + 2097152;
constexpr size_t WS_WFF1 = WS_WO + 2097152;
constexpr size_t WS_WFF2 = WS_WFF1 + 8388608;
constexpr size_t WS_RQ = WS_WFF2 + 8388608;
constexpr size_t WS_RK = WS_RQ + SZ_ACT / 2;
constexpr size_t WS_RV = WS_RK + SZ_ACT / 2;
constexpr size_t WS_RG = WS_RV + SZ_ACT;
constexpr size_t WS_FQ = WS_RG + SZ_ACT;
constexpr size_t WS_FK = WS_FQ + SZ_ACT;
constexpr size_t WS_VT = WS_FK + SZ_ACT;
constexpr size_t WS_LOGF = WS_VT + (size_t)4 * 8 * 128 * LP * 2;
constexpr size_t WS_NCKP = WS_LOGF + (size_t)MT * 8 * 4;
constexpr size_t WS_NCKS = WS_NCKP + (size_t)32 * LP * 4;
constexpr size_t WS_ROPE = WS_NCKS + (size_t)64 * 4128 * 4;
constexpr size_t WS_SSQ = WS_ROPE + (size_t)LP * 64 * 8;
constexpr size_t WS_GAS = WS_SSQ + (size_t)MT * 8 * 4;
constexpr size_t WS_GBS = WS_GAS + 524288;
constexpr size_t WS_SSQS = WS_GBS + 524288;
constexpr size_t WS_BAR = WS_SSQS + 32768;
constexpr size_t WS_END = WS_BAR + 16384;
constexpr size_t WS_TG = WS_XN;
constexpr size_t WS_M = WS_RV;
constexpr size_t WS_A2 = WS_FK;
constexpr size_t WS_U = WS_RQ;
static_assert(WS_END <= (size_t)512 * 1024 * 1024, "workspace too large");
static_assert(WS_U + (size_t)MT * 4096 * 2 == WS_FK, "U alias");

constexpr size_t O_Y = 0, O_YS = 33554432, O_PST = O_YS + 262144, O_PK = O_PST + 524288, O_PV = O_PK + 33619968, O_PLF = O_PV + 33619968,
                 O_SST = O_PLF + 262656, O_SK = O_SST + 1048576, O_SV = O_SK + 262144, O_SLF = O_SV + 262144;

struct Params {
    const float* x_prompt; const float* x_sample; const float* state_ret; const float* cache_k; const float* cache_v; const float* cache_logf;
    const float* meta; const float* norm1_g; const float* w_in; const float* b_forget; const float* q_norm_g; const float* k_norm_g; const float* ret_gn_g;
    const float* w_ret_out; const float* w_fox_out; const float* w_o; const float* norm2_g; const float* w_ff1; const float* w_ff2;
    float* out; unsigned char* ws; int ph_lo, ph_hi, coop, pad;
};

DI unsigned pk2(float a, float b) { f32x2 v = {a, b}; bf2_t r = __builtin_convertvector(v, bf2_t); return __builtin_bit_cast(unsigned, r); }
DI bf16_t f2bf(float a) { return (bf16_t)(pk2(a, 0.f) & 0xffffu); }
DI float bflo(unsigned u) { return __uint_as_float(u << 16); }
DI float bfhi(unsigned u) { return __uint_as_float(u & 0xffff0000u); }
DI float bf2f(bf16_t u) { return __uint_as_float(((unsigned)u) << 16); }
DI int crow(int i, int h) { return (i & 3) + 8 * (i >> 2) + 4 * h; }
DI float ex2(float x) { return __builtin_amdgcn_exp2f(x); }
DI float frcp(float x) { return __builtin_amdgcn_rcpf(x); }
DI float frsq(float x) { return __builtin_amdgcn_rsqf(x); }
DI bf16x8 pack8(const f32x16& x, int s) {
    u32x4 p; p.x = pk2(x[8 * s], x[8 * s + 1]); p.y = pk2(x[8 * s + 2], x[8 * s + 3]); p.z = pk2(x[8 * s + 4], x[8 * s + 5]); p.w = pk2(x[8 * s + 6], x[8 * s + 7]);
    return __builtin_bit_cast(bf16x8, p);
}
DI bf16x8 cat4(s16x4 lo, s16x4 hi) { return __builtin_shufflevector(lo, hi, 0, 1, 2, 3, 4, 5, 6, 7); }
DI float wave_sum(float v) {
#pragma unroll
    for (int o = 1; o < 64; o <<= 1) v += __shfl_xor(v, o);
    return v;
}
DI float half_sum32(float v) {
#pragma unroll
    for (int o = 1; o < 32; o <<= 1) v += __shfl_xor(v, o);
    return v;
}
DI void decode_row(int r, int& samp, int& b, int& p) {
    if (r < MPR) { samp = 0; b = r / LP; p = r - b * LP; } else { samp = 1; const int s = r - MPR; b = s >> 5; p = s & 31; }
}
DI int opaque_tid() { int t = threadIdx.x; asm volatile("" : "+v"(t)); return t; }
DI f32x16 zero16() { f32x16 z; for (int i = 0; i < 16; ++i) z[i] = 0.f; return z; }

DI void p0_rows(const Params& P, unsigned char* lds) {
    float* wffT = (float*)lds;
    const int t = opaque_tid();
#pragma unroll
    for (int i = 0; i < 16; ++i) { const int idx = t + 512 * i; const int c = idx >> 3, h = idx & 7; wffT[h * 1024 + c] = P.w_in[(size_t)c * INW + 6144 + h]; }
    __syncthreads();
    const int lane = t & 63, wave = t >> 6;
    bf16_t* XN = (bf16_t*)(P.ws + WS_XN); float* LOGF = (float*)(P.ws + WS_LOGF);
    for (int r = blockIdx.x * 8 + wave; r < MT; r += gridDim.x * 8) {
        int samp, b, p; decode_row(r, samp, b, p);
        const float* src = nullptr;
        if (samp) src = P.x_sample + (size_t)(r - MPR) * D;
        else if (p >= OFF) src = P.x_prompt + ((size_t)b * 8192 + (p - OFF)) * D;
        else if (p >= VAL0) src = P.meta + (size_t)(p - VAL0) * D;
        f32x4 v[4]; float ss = 0.f;
#pragma unroll
        for (int j = 0; j < 4; ++j) {
            if (src) v[j] = *(const f32x4*)(src + 4 * lane + 256 * j); else v[j] = (f32x4){0.f, 0.f, 0.f, 0.f};
            ss += v[j].x * v[j].x + v[j].y * v[j].y + v[j].z * v[j].z + v[j].w * v[j].w;
        }
        ss = wave_sum(ss);
        const float rstd = frsq(ss * (1.f / 1024.f) + EPS);
        float dot[8];
#pragma unroll
        for (int h = 0; h < 8; ++h) dot[h] = 0.f;
#pragma unroll
        for (int j = 0; j < 4; ++j) {
            const f32x4 g = *(const f32x4*)(P.norm1_g + 4 * lane + 256 * j);
            v[j] = v[j] * rstd * g;
            u32x2 o; o.x = pk2(v[j].x, v[j].y); o.y = pk2(v[j].z, v[j].w);
            *(u32x2*)(XN + (size_t)r * D + 4 * lane + 256 * j) = o;
#pragma unroll
            for (int h = 0; h < 8; ++h) { const f32x4 w = *(const f32x4*)(wffT + h * 1024 + 4 * lane + 256 * j); dot[h] += v[j].x * w.x + v[j].y * w.y + v[j].z * w.z + v[j].w * w.w; }
        }
#pragma unroll
        for (int h = 0; h < 8; ++h) dot[h] = wave_sum(dot[h]);
        float mine = dot[0];
#pragma unroll
        for (int h = 1; h < 8; ++h) mine = (lane == h) ? dot[h] : mine;
        if (lane < 8) {
            const float vv = mine + P.b_forget[lane];
            float lf = fminf(vv, 0.f) - log1pf(__expf(-fabsf(vv)));
            if (!samp && p < VAL0) lf = 0.f;
            LOGF[(size_t)r * 8 + lane] = lf;
            if (samp) P.out[O_SLF + (size_t)(r - MPR) * 8 + lane] = lf;
            else if (p >= VAL0) P.out[O_PLF + ((size_t)b * 8208 + (p - VAL0)) * 8 + lane] = lf;
        }
    }
    __syncthreads();
}

DI void transpose_item(const float* W, int ldw, int col0, int K, bf16_t* WT, int n0, int k0, float* tile) {
    const int t = opaque_tid(); const int nn = t & 63, kb = t >> 6;
#pragma unroll
    for (int i = 0; i < 8; ++i) { const int kk = kb + 8 * i; tile[kk * 65 + nn] = W[(size_t)(k0 + kk) * ldw + col0 + nn]; }
    __syncthreads();
    const int n = t >> 3, kc = t & 7;
    float f[8];
#pragma unroll
    for (int e = 0; e < 8; ++e) f[e] = tile[(8 * kc + e) * 65 + n];
    u32x4 o; o.x = pk2(f[0], f[1]); o.y = pk2(f[2], f[3]); o.z = pk2(f[4], f[5]); o.w = pk2(f[6], f[7]);
    *(u32x4*)(WT + (size_t)(n0 + n) * K + k0 + 8 * kc) = o;
    __syncthreads();
}

DI void p0_weights(const Params& P, unsigned char* lds) {
    float* tile = (float*)lds;
    constexpr int I0 = 16 * 128, I1 = 256, I4 = 16 * 64, I5 = 64 * 16;
    constexpr int NIT = I0 + 3 * I1 + I4 + I5;
    for (int it = blockIdx.x; it < NIT; it += gridDim.x) {
        int r = it;
        if (r < I0) { const int kt = r / 128, nt = r % 128; const int n0 = nt * 64; transpose_item(P.w_in, INW, n0 + (n0 >= 6144 ? 8 : 0), 1024, (bf16_t*)(P.ws + WS_WIN), n0, kt * 64, tile); continue; } r -= I0;
        if (r < I1) { transpose_item(P.w_ret_out, 1024, (r % 16) * 64, 1024, (bf16_t*)(P.ws + WS_WRET), (r % 16) * 64, (r / 16) * 64, tile); continue; } r -= I1;
        if (r < I1) { transpose_item(P.w_fox_out, 1024, (r % 16) * 64, 1024, (bf16_t*)(P.ws + WS_WFOX), (r % 16) * 64, (r / 16) * 64, tile); continue; } r -= I1;
        if (r < I1) { transpose_item(P.w_o, 1024, (r % 16) * 64, 1024, (bf16_t*)(P.ws + WS_WO), (r % 16) * 64, (r / 16) * 64, tile); continue; } r -= I1;
        if (r < I4) { transpose_item(P.w_ff1, 4096, (r % 64) * 64, 1024, (bf16_t*)(P.ws + WS_WFF1), (r % 64) * 64, (r / 64) * 64, tile); continue; } r -= I4;
        transpose_item(P.w_ff2, 1024, (r % 16) * 64, 4096, (bf16_t*)(P.ws + WS_WFF2), (r % 16) * 64, (r / 16) * 64, tile);
    }
}

DI void p0_misc(const Params& P) {
    f32x2* ROPE = (f32x2*)(P.ws + WS_ROPE);
    for (int idx = blockIdx.x * 512 + threadIdx.x; idx < LP * 64; idx += gridDim.x * 512) {
        const int pp = idx >> 6, c = idx & 63;
        const float pos = (float)(pp - 128);
        const float inv = exp2f(-(float)c * (13.287712379549449f / 64.f));
        const float ang = pos * inv;
        double td = (double)ang * 0.15915494309189535; td -= __builtin_rint(td);
        const float tf = (float)td;
        f32x2 cs; cs.x = __builtin_amdgcn_cosf(tf); cs.y = __builtin_amdgcn_sinf(tf);
        ROPE[idx] = cs;
    }
}

#define AS_GLOBAL __attribute__((address_space(1)))
#define AS_LDS __attribute__((address_space(3)))
DI void dma16(const void* g, unsigned char* l) { __builtin_amdgcn_global_load_lds((const AS_GLOBAL unsigned*)g, (AS_LDS unsigned*)l, 16, 0, 0); }
template <int NBW>
DI void gemm_mainloop(f32x16 (&acc)[2][NBW], const bf16_t* A, size_t lda, int m0, const bf16_t* Bt, size_t ldb, int n0, int K, unsigned char* lds, bool pre = false, bool only_issue = false) {
    constexpr int STAGE = 65536, BOFF = 32768;
    const int t = opaque_tid(), w = t >> 6, lane = t & 63, r = lane & 31, hh = lane >> 5, wm = w >> 1, wn = w & 1;
    const int drow = w * 8 + (lane >> 3);
    const int lchunk = (lane & 7) ^ ((drow >> 1) & 7);
    const bf16_t* ap = A + (size_t)(m0 + drow) * lda + lchunk * 8;
    const bf16_t* bp = Bt + (size_t)n0 * ldb + lchunk * 8;
    size_t bro[NBW];
#pragma unroll
    for (int j = 0; j < NBW; ++j) {
        const int rho = 64 * j + drow; const int wnh = rho / (32 * NBW), wi = rho % (32 * NBW);
        bro[j] = (size_t)(wnh * 32 * NBW + NBW * (wi & 31) + (wi >> 5)) * ldb;
    }
    unsigned char* ldst = lds + w * 1024 + lane * 16;
#define GEMM_ISSUE(KT, ST) do { const int k1_ = (KT) << 6; unsigned char* d_ = ldst + (ST) * STAGE; \
        _Pragma("unroll") for (int j_ = 0; j_ < 4; ++j_) dma16(ap + (size_t)(64 * j_) * lda + k1_, d_ + j_ * 8192); \
        _Pragma("unroll") for (int j_ = 0; j_ < NBW; ++j_) dma16(bp + bro[j_] + k1_, d_ + BOFF + j_ * 8192); } while (0)
    if (!pre) GEMM_ISSUE(0, 0);
    if (only_issue) return;
    __syncthreads();
    const int nk = K >> 6;
    const int xr = (r >> 1) & 7;
    int xo[4];
#pragma unroll
    for (int s = 0; s < 4; ++s) xo[s] = ((2 * s + hh) ^ xr) << 4;
    const int aofs = (wm * 64 + r) * 128;
    const int bofs = BOFF + (wn * 32 * NBW + r) * 128;
#pragma unroll 1
    for (int kt = 0; kt < nk; ++kt) {
        const unsigned char* st = lds + (kt & 1) * STAGE;
#pragma unroll
        for (int s = 0; s < 4; ++s) {
            if (s == 1 && kt + 1 < nk) GEMM_ISSUE(kt + 1, (kt + 1) & 1);
            bf16x8 a[2], b[NBW];
#pragma unroll
            for (int mb = 0; mb < 2; ++mb) a[mb] = *(const bf16x8*)(st + aofs + mb * 4096 + xo[s]);
#pragma unroll
            for (int nb = 0; nb < NBW; ++nb) b[nb] = *(const bf16x8*)(st + bofs + nb * 4096 + xo[s]);
#pragma unroll
            for (int mb = 0; mb < 2; ++mb)
#pragma unroll
                for (int nb = 0; nb < NBW; ++nb) acc[mb][nb] = MFMA(a[mb], b[nb], acc[mb][nb]);
        }
        __syncthreads();
    }
#undef GEMM_ISSUE
}

DI void epi_p1(const Params& P, f32x16 (&acc)[2][4], int m0, int n0) {
    const int t = opaque_tid(), w = t >> 6, lane = t & 63, r = lane & 31, hh = lane >> 5, wm = w >> 1, wn = w & 1;
    const int seg = (n0 + wn * 128) >> 7;
    unsigned char* ws = P.ws; float* out = P.out;
    const int rbase = m0 + wm * 64 + 4 * hh;
    const int c4 = 4 * r;
    if (seg < 8) {
        const bool isk = seg >= 4; const int head = seg & 3;
        bf16_t* dst = (bf16_t*)(ws + (isk ? WS_RK : WS_RQ)); const float scl = isk ? 0.08838834764831845f : 1.f;
        const float* rope = (const float*)(ws + WS_ROPE);
        const float sgn = (r < 16) ? -1.f : 1.f; const int f4 = 4 * (r & 15);
#pragma unroll
        for (int mb = 0; mb < 2; ++mb)
#pragma unroll
            for (int g = 0; g < 4; ++g) {
                const int rowb = rbase + mb * 32 + 8 * g; int samp, b, p0; decode_row(rowb, samp, b, p0);
                const int ridx0 = samp ? 4224 + p0 : p0;
#pragma unroll
                for (int e = 0; e < 4; ++e) {
                    const int i = 4 * g + e; const size_t row = rowb + e;
                    const f32x4 cs0 = *(const f32x4*)(rope + ((size_t)(ridx0 + e) * 64 + f4) * 2), cs1 = *(const f32x4*)(rope + ((size_t)(ridx0 + e) * 64 + f4) * 2 + 4);
                    const float cc[4] = {cs0.x, cs0.z, cs1.x, cs1.z}, sn[4] = {cs0.y, cs0.w, cs1.y, cs1.w};
                    float o[4];
#pragma unroll
                    for (int nb = 0; nb < 4; ++nb) { const float v = acc[mb][nb][i]; const float pv = __shfl_xor(v, 16); o[nb] = (v * cc[nb] + sgn * pv * sn[nb]) * scl; }
                    u32x2 ov; ov.x = pk2(o[0], o[1]); ov.y = pk2(o[2], o[3]);
                    __builtin_nontemporal_store(ov, (u32x2*)(dst + row * 512 + head * 128 + c4));
                }
            }
    } else if (seg < 24) {
        bf16_t* dst = (bf16_t*)(ws + (seg < 16 ? WS_RV : WS_RG)); const int cb = (seg & 7) * 128 + c4;
#pragma unroll
        for (int mb = 0; mb < 2; ++mb)
#pragma unroll
            for (int i = 0; i < 16; ++i) {
                const size_t row = rbase + mb * 32 + (i & 3) + 8 * (i >> 2);
                u32x2 ov; ov.x = pk2(acc[mb][0][i], acc[mb][1][i]); ov.y = pk2(acc[mb][2][i], acc[mb][3][i]);
                __builtin_nontemporal_store(ov, (u32x2*)(dst + row * 1024 + cb));
            }
    } else if (seg < 40) {
        const bool isk = seg >= 32; const int head = seg & 7;
        const f32x4 gv = *(const f32x4*)((isk ? P.k_norm_g : P.q_norm_g) + c4);
        bf16_t* dst = (bf16_t*)(ws + (isk ? WS_FK : WS_FQ));
#pragma unroll
        for (int mb = 0; mb < 2; ++mb)
#pragma unroll
            for (int g = 0; g < 4; ++g) {
                const int rowb = rbase + mb * 32 + 8 * g; int samp, b, p0; decode_row(rowb, samp, b, p0);
#pragma unroll
                for (int e = 0; e < 4; ++e) {
                    const int i = 4 * g + e; const size_t row = rowb + e; const int p = p0 + e;
                    float ss = 0.f;
#pragma unroll
                    for (int nb = 0; nb < 4; ++nb) ss += acc[mb][nb][i] * acc[mb][nb][i];
                    ss = half_sum32(ss);
                    const float rstd = frsq(ss * (1.f / 128.f) + EPS);
                    f32x4 y; y.x = acc[mb][0][i] * rstd * gv.x; y.y = acc[mb][1][i] * rstd * gv.y; y.z = acc[mb][2][i] * rstd * gv.z; y.w = acc[mb][3][i] * rstd * gv.w;
                    u32x2 ov; ov.x = pk2(y.x, y.y); ov.y = pk2(y.z, y.w);
                    __builtin_nontemporal_store(ov, (u32x2*)(dst + row * 1024 + head * 128 + c4));
                    if (isk) {
                        if (samp) __builtin_nontemporal_store(y, (f32x4*)(out + O_SK + ((size_t)(b * 32 + p) * 8 + head) * 128 + c4));
                        else if (p >= VAL0) __builtin_nontemporal_store(y, (f32x4*)(out + O_PK + (((size_t)b * 8208 + (p - VAL0)) * 8 + head) * 128 + c4));
                    }
                }
            }
    } else if (seg < 48) {
        const int head = seg & 7; bf16_t* VT = (bf16_t*)(ws + WS_VT);
#pragma unroll
        for (int mb = 0; mb < 2; ++mb)
#pragma unroll
            for (int g = 0; g < 4; ++g) {
                const int rowb = rbase + mb * 32 + 8 * g; int samp, b, p0; decode_row(rowb, samp, b, p0);
#pragma unroll
                for (int e = 0; e < 4; ++e) {
                    const int i = 4 * g + e; const int p = p0 + e;
                    f32x4 y; y.x = acc[mb][0][i]; y.y = acc[mb][1][i]; y.z = acc[mb][2][i]; y.w = acc[mb][3][i];
                    if (samp) __builtin_nontemporal_store(y, (f32x4*)(out + O_SV + ((size_t)(b * 32 + p) * 8 + head) * 128 + c4));
                    else if (p >= VAL0) __builtin_nontemporal_store(y, (f32x4*)(out + O_PV + (((size_t)b * 8208 + (p - VAL0)) * 8 + head) * 128 + c4));
                }
                if (!samp) {
#pragma unroll
                    for (int nb = 0; nb < 4; ++nb) {
                        u32x2 o; o.x = pk2(acc[mb][nb][4 * g], acc[mb][nb][4 * g + 1]); o.y = pk2(acc[mb][nb][4 * g + 2], acc[mb][nb][4 * g + 3]);
                        *(u32x2*)(VT + ((size_t)((b * 8 + head) * 128 + c4 + nb)) * LP + p0) = o;
                    }
                }
            }
    } else {
        const bool isb = seg >= 56; const int cb = (seg & 7) * 128 + c4;
        bf16_t* dp = (bf16_t*)out + (isb ? (size_t)33554432 : 0);
        bf16_t* dsm = (bf16_t*)(ws + (isb ? WS_GBS : WS_GAS));
#pragma unroll
        for (int mb = 0; mb < 2; ++mb)
#pragma unroll
            for (int g = 0; g < 4; ++g) {
                const int rowb = rbase + mb * 32 + 8 * g; int samp, b, p0; decode_row(rowb, samp, b, p0);
#pragma unroll
                for (int e = 0; e < 4; ++e) {
                    const int i = 4 * g + e; const int p = p0 + e;
                    bf16_t* d = nullptr;
                    if (samp) d = dsm + (size_t)(b * 32 + p) * 1024; else if (p >= OFF) d = dp + ((size_t)b * 8192 + (p - OFF)) * 1024;
                    if (d) {
                        float s[4];
#pragma unroll
                        for (int nb = 0; nb < 4; ++nb) s[nb] = frcp(1.f + ex2(-LOG2E * acc[mb][nb][i]));
                        u32x2 ov; ov.x = pk2(s[0], s[1]); ov.y = pk2(s[2], s[3]);
                        __builtin_nontemporal_store(ov, (u32x2*)(d + cb));
                    }
                }
            }
    }
}

DI void phase_p1(const Params& P, unsigned char* lds) {
    const bf16_t* A = (const bf16_t*)(P.ws + WS_XN); const bf16_t* Bt = (const bf16_t*)(P.ws + WS_WIN);
    constexpr int NTN = 32;
    bool pre = false;
#pragma unroll 1
    for (int tile = blockIdx.x; tile < NTM * NTN; tile += gridDim.x) {
        const int mt = tile / NTN, nt = tile % NTN;
        f32x16 acc[2][4];
#pragma unroll
        for (int a = 0; a < 2; ++a)
#pragma unroll
            for (int b = 0; b < 4; ++b) acc[a][b] = zero16();
        gemm_mainloop<4>(acc, A, 1024, mt * 256, Bt, 1024, nt * 256, 1024, lds, pre);
        { const int tn = tile + gridDim.x; pre = tn < NTM * NTN; if (pre) { const int mtn = tn / NTN, ntn_ = tn % NTN; f32x16 (&dummy)[2][4] = acc; gemm_mainloop<4>(dummy, A, 1024, mtn * 256, Bt, 1024, ntn_ * 256, 1024, lds, false, true); } }
        epi_p1(P, acc, mt * 256, nt * 256);
    }
}

DI void small_tile(const bf16_t* A, size_t lda, int a0, const bf16_t* Bt, size_t ldb, int b0, int K, float* ctile, float* red) {
    const int t = opaque_tid(), w = t >> 6, lane = t & 63, r = lane & 31, hh = lane >> 5;
    const int kper = K >> 3;
    const bf16_t* ap = A + (size_t)(a0 + r) * lda + w * kper + 8 * hh;
    const bf16_t* bp = Bt + (size_t)(b0 + r) * ldb + w * kper + 8 * hh;
    f32x16 acc = zero16();
#pragma unroll 4
    for (int k = 0; k < kper; k += 16) acc = MFMA(*(const bf16x8*)(ap + k), *(const bf16x8*)(bp + k), acc);
#pragma unroll
    for (int i = 0; i < 16; ++i) red[w * 1024 + i * 64 + lane] = acc[i];
    __syncthreads();
#pragma unroll
    for (int q = 0; q < 2; ++q) {
        const int e = t + 512 * q; float s = 0.f;
#pragma unroll
        for (int ww = 0; ww < 8; ++ww) s += red[ww * 1024 + e];
        const int i = e >> 6, ln = e & 63;
        ctile[crow(i, ln >> 5) * 33 + (ln & 31)] = s;
    }
    __syncthreads();
}

DI void phase_p4(const Params& P, unsigned char* lds) {
    const bf16_t* RO = (const bf16_t*)(P.ws + WS_RG); const bf16_t* FO = (const bf16_t*)(P.ws + WS_FQ);
    const bf16_t* W1 = (const bf16_t*)(P.ws + WS_WRET); const bf16_t* W2 = (const bf16_t*)(P.ws + WS_WFOX);
    bf16_t* M = (bf16_t*)(P.ws + WS_M);
    const bf16_t* GAp = (const bf16_t*)P.out; const bf16_t* GBp = GAp + (size_t)33554432;
    const bf16_t* GAs = (const bf16_t*)(P.ws + WS_GAS); const bf16_t* GBs = (const bf16_t*)(P.ws + WS_GBS);
    const int t = opaque_tid(), w = t >> 6, lane = t & 63, r = lane & 31, hh = lane >> 5, wm = w >> 1, wn = w & 1;
    constexpr int NTN = 8;
    bool pre = false;
#pragma unroll 1
    for (int tile = blockIdx.x; tile < 128 * NTN; tile += gridDim.x) {
        const int mt = tile / NTN, nt = tile % NTN; const int m0 = (mt >> 5) * LP + OFF + (mt & 31) * 256, n0 = nt * 128;
        f32x16 a1[2][2], a2[2][2];
#pragma unroll
        for (int a = 0; a < 2; ++a)
#pragma unroll
            for (int b = 0; b < 2; ++b) { a1[a][b] = zero16(); a2[a][b] = zero16(); }
        gemm_mainloop<2>(a1, RO, 1024, m0, W1, 1024, n0, 1024, lds, pre);
        gemm_mainloop<2>(a2, FO, 1024, m0, W2, 1024, n0, 1024, lds);
        { const int tn = tile + gridDim.x; pre = tn < 128 * NTN; if (pre) { const int mtn = tn / NTN, ntn_ = tn % NTN; gemm_mainloop<2>(a1, RO, 1024, (mtn >> 5) * LP + OFF + (mtn & 31) * 256, W1, 1024, ntn_ * 128, 1024, lds, false, true); } }
        const int col = n0 + wn * 64 + 2 * r;
        const size_t crow0 = (size_t)mt * 256 + wm * 64 + 4 * hh;
#pragma unroll
        for (int mb = 0; mb < 2; ++mb) {
            unsigned ua[16], ub[16];
#pragma unroll
            for (int i = 0; i < 16; ++i) {
                const size_t ci = (crow0 + mb * 32 + (i & 3) + 8 * (i >> 2)) * 1024 + col;
                ua[i] = *(const unsigned*)(GAp + ci); ub[i] = *(const unsigned*)(GBp + ci);
            }
#pragma unroll
            for (int i = 0; i < 16; ++i) {
                const size_t row = (size_t)m0 + wm * 64 + mb * 32 + crow(i, hh);
                const float m0v = bflo(ua[i]) * a1[mb][0][i] + bflo(ub[i]) * a2[mb][0][i];
                const float m1v = bfhi(ua[i]) * a1[mb][1][i] + bfhi(ub[i]) * a2[mb][1][i];
                __builtin_nontemporal_store(pk2(m0v, m1v), (unsigned*)(M + row * 1024 + col));
            }
        }
    }
    {
        float* red = (float*)lds; float* c1 = (float*)(lds + 32768); float* c2 = (float*)(lds + 32768 + 4352);
#pragma unroll 1
        for (int pc = blockIdx.x; pc < 8 * 32; pc += gridDim.x) {
            const int rg = pc >> 5, cg = pc & 31;
            small_tile(RO, 1024, MPR + 32 * rg, W1, 1024, 32 * cg, 1024, c1, red);
            small_tile(FO, 1024, MPR + 32 * rg, W2, 1024, 32 * cg, 1024, c2, red);
            const int rl = t >> 4, cl = (t & 15) * 2; const int srow = 32 * rg + rl, col = 32 * cg + cl;
            const unsigned ua = *(const unsigned*)(GAs + (size_t)srow * 1024 + col), ub = *(const unsigned*)(GBs + (size_t)srow * 1024 + col);
            const float m0v = bflo(ua) * c1[rl * 33 + cl] + bflo(ub) * c2[rl * 33 + cl];
            const float m1v = bfhi(ua) * c1[rl * 33 + cl + 1] + bfhi(ub) * c2[rl * 33 + cl + 1];
            __builtin_nontemporal_store(pk2(m0v, m1v), (unsigned*)(M + (size_t)(MPR + srow) * 1024 + col));
            __syncthreads();
        }
    }
}

DI void phase_p5(const Params& P, unsigned char* lds) {
    const bf16_t* M = (const bf16_t*)(P.ws + WS_M); const bf16_t* W = (const bf16_t*)(P.ws + WS_WO);
    bf16_t* A2 = (bf16_t*)(P.ws + WS_A2); float* SSQ = (float*)(P.ws + WS_SSQ);
    const int t = opaque_tid(), w = t >> 6, lane = t & 63, r = lane & 31, hh = lane >> 5, wm = w >> 1, wn = w & 1;
    constexpr int NTN = 4;
    bool pre = false;
#pragma unroll 1
    for (int tile = blockIdx.x; tile < 128 * NTN; tile += gridDim.x) {
        const int mt = tile / NTN, nt = tile % NTN; const int m0 = (mt >> 5) * LP + OFF + (mt & 31) * 256, n0 = nt * 256;
        f32x16 acc[2][4];
#pragma unroll
        for (int a = 0; a < 2; ++a)
#pragma unroll
            for (int b = 0; b < 4; ++b) acc[a][b] = zero16();
        gemm_mainloop<4>(acc, M, 1024, m0, W, 1024, n0, 1024, lds, pre);
        { const int tn = tile + gridDim.x; pre = tn < 128 * NTN; if (pre) { const int mtn = tn / NTN, ntn_ = tn % NTN; f32x16 (&dummy)[2][4] = acc; gemm_mainloop<4>(dummy, M, 1024, (mtn >> 5) * LP + OFF + (mtn & 31) * 256, W, 1024, ntn_ * 256, 1024, lds, false, true); } }
        const int col = n0 + wn * 128 + 4 * r;
        const f32x4 g2 = *(const f32x4*)(P.norm2_g + col);
        const size_t crow0 = (size_t)mt * 256 + wm * 64 + 4 * hh;
#pragma unroll
        for (int mb = 0; mb < 2; ++mb) {
#pragma unroll
          for (int hf = 0; hf < 2; ++hf) {
            f32x4 xv[16];
#pragma unroll
            for (int i = 8 * hf; i < 8 * hf + 8; ++i) xv[i] = *(const f32x4*)(P.x_prompt + (crow0 + mb * 32 + (i & 3) + 8 * (i >> 2)) * 1024 + col);
#pragma unroll
            for (int i = 8 * hf; i < 8 * hf + 8; ++i) {
                const size_t lr = mb * 32 + (i & 3) + 8 * (i >> 2); const size_t row = (size_t)m0 + wm * 64 + 4 * hh + lr;
                f32x4 h2; h2.x = xv[i].x + acc[mb][0][i]; h2.y = xv[i].y + acc[mb][1][i]; h2.z = xv[i].z + acc[mb][2][i]; h2.w = xv[i].w + acc[mb][3][i];
                __builtin_nontemporal_store(h2, (f32x4*)(P.out + O_Y + (crow0 + lr) * 1024 + col));
                u32x2 ov; ov.x = pk2(h2.x * g2.x, h2.y * g2.y); ov.y = pk2(h2.z * g2.z, h2.w * g2.w);
                __builtin_nontemporal_store(ov, (u32x2*)(A2 + row * 1024 + col));
                float ss = (h2.x * h2.x + h2.y * h2.y) + (h2.z * h2.z + h2.w * h2.w);
                ss = half_sum32(ss);
                if (r == 0) SSQ[row * 8 + nt * 2 + wn] = ss;
            }
          }
        }
    }
    {
        float* red = (float*)lds; float* c1 = (float*)(lds + 32768); float* SSQS = (float*)(P.ws + WS_SSQS);
#pragma unroll 1
        for (int pc = blockIdx.x; pc < 8 * 32; pc += gridDim.x) {
            const int rg = pc >> 5, cg = pc & 31;
            small_tile(M, 1024, MPR + 32 * rg, W, 1024, 32 * cg, 1024, c1, red);
            const int rl = t >> 4, cl = (t & 15) * 2; const int srow = 32 * rg + rl, col = 32 * cg + cl;
            const f32x2 xv = *(const f32x2*)(P.x_sample + (size_t)srow * 1024 + col);
            f32x2 h2; h2.x = xv.x + c1[rl * 33 + cl]; h2.y = xv.y + c1[rl * 33 + cl + 1];
            __builtin_nontemporal_store(h2, (f32x2*)(P.out + O_YS + (size_t)srow * 1024 + col));
            const f32x2 g2 = *(const f32x2*)(P.norm2_g + col);
            __builtin_nontemporal_store(pk2(h2.x * g2.x, h2.y * g2.y), (unsigned*)(A2 + (size_t)(MPR + srow) * 1024 + col));
            float ss = h2.x * h2.x + h2.y * h2.y;
#pragma unroll
            for (int o = 1; o < 16; o <<= 1) ss += __shfl_xor(ss, o);
            if ((t & 15) == 0) SSQS[srow * 32 + cg] = ss;
            __syncthreads();
        }
    }
}

DI void phase_p6(const Params& P, unsigned char* lds) {
    const bf16_t* A2 = (const bf16_t*)(P.ws + WS_A2); const bf16_t* W = (const bf16_t*)(P.ws + WS_WFF1);
    bf16_t* U = (bf16_t*)(P.ws + WS_U); const float* SSQ = (const float*)(P.ws + WS_SSQ);
    const int t = opaque_tid(), w = t >> 6, lane = t & 63, r = lane & 31, hh = lane >> 5, wm = w >> 1, wn = w & 1;
    constexpr int NTN = 16;
    bool pre = false; int rtpar = 0;
#pragma unroll 1
    for (int tile = blockIdx.x; tile < 128 * NTN; tile += gridDim.x) {
        const int mt = tile / NTN, nt = tile % NTN; const int m0 = (mt >> 5) * LP + OFF + (mt & 31) * 256, n0 = nt * 256;
        f32x16 acc[2][4];
#pragma unroll
        for (int a = 0; a < 2; ++a)
#pragma unroll
            for (int b = 0; b < 4; ++b) acc[a][b] = zero16();
        {
            float* rt = (float*)(lds + 131072 + (rtpar & 1) * 1024);
            if (t < 256) {
                const size_t row = (size_t)m0 + t;
                const f32x4 s0 = *(const f32x4*)(SSQ + row * 8), s1 = *(const f32x4*)(SSQ + row * 8 + 4);
                const float ss = ((s0.x + s0.y) + (s0.z + s0.w)) + ((s1.x + s1.y) + (s1.z + s1.w));
                rt[t] = frsq(ss * (1.f / 1024.f) + EPS);
            }
        }
        gemm_mainloop<4>(acc, A2, 1024, m0, W, 1024, n0, 1024, lds, pre);
        { const int tn = tile + gridDim.x; pre = tn < 128 * NTN; if (pre) { const int mtn = tn / NTN, ntn_ = tn % NTN; f32x16 (&dummy)[2][4] = acc; gemm_mainloop<4>(dummy, A2, 1024, (mtn >> 5) * LP + OFF + (mtn & 31) * 256, W, 1024, ntn_ * 256, 1024, lds, false, true); } }
        const int col = n0 + wn * 128 + 4 * r;
#pragma unroll
        for (int mb = 0; mb < 2; ++mb)
#pragma unroll
            for (int i = 0; i < 16; ++i) {
                const size_t row = m0 + wm * 64 + mb * 32 + crow(i, hh);
                const float rstd = ((const float*)(lds + 131072 + (rtpar & 1) * 1024))[wm * 64 + mb * 32 + crow(i, hh)];
                float u[4];
#pragma unroll
                for (int nb = 0; nb < 4; ++nb) { const float v = fmaxf(acc[mb][nb][i] * rstd, 0.f); u[nb] = v * v; }
                u32x2 ov; ov.x = pk2(u[0], u[1]); ov.y = pk2(u[2], u[3]);
                __builtin_nontemporal_store(ov, (u32x2*)(U + row * 4096 + col));
            }
        ++rtpar;
    }
    {
        float* red = (float*)lds; float* c1 = (float*)(lds + 32768); const float* SSQS = (const float*)(P.ws + WS_SSQS);
#pragma unroll 1
        for (int pc = blockIdx.x; pc < 8 * 128; pc += gridDim.x) {
            const int rg = pc >> 7, cg = pc & 127;
            small_tile(A2, 1024, MPR + 32 * rg, W, 1024, 32 * cg, 1024, c1, red);
            const int rl = t >> 4, cl = (t & 15) * 2; const int srow = 32 * rg + rl, col = 32 * cg + cl;
            float ss = 0.f;
#pragma unroll
            for (int j = 0; j < 8; ++j) { const f32x4 sv = *(const f32x4*)(SSQS + srow * 32 + 4 * j); ss += (sv.x + sv.y) + (sv.z + sv.w); }
            const float rstd = frsq(ss * (1.f / 1024.f) + EPS);
            const float u0 = fmaxf(c1[rl * 33 + cl] * rstd, 0.f), u1 = fmaxf(c1[rl * 33 + cl + 1] * rstd, 0.f);
            __builtin_nontemporal_store(pk2(u0 * u0, u1 * u1), (unsigned*)(U + (size_t)(MPR + srow) * 4096 + col));
            __syncthreads();
        }
    }
}

DI void phase_p7(const Params& P, unsigned char* lds) {
    const bf16_t* U = (const bf16_t*)(P.ws + WS_U); const bf16_t* W = (const bf16_t*)(P.ws + WS_WFF2);
    const int t = opaque_tid(), w = t >> 6, lane = t & 63, r = lane & 31, hh = lane >> 5, wm = w >> 1, wn = w & 1;
    constexpr int NTN = 4;
    bool pre = false;
#pragma unroll 1
    for (int tile = blockIdx.x; tile < 128 * NTN; tile += gridDim.x) {
        const int mt = tile / NTN, nt = tile % NTN; const int m0 = (mt >> 5) * LP + OFF + (mt & 31) * 256, n0 = nt * 256;
        f32x16 acc[2][4];
#pragma unroll
        for (int a = 0; a < 2; ++a)
#pragma unroll
            for (int b = 0; b < 4; ++b) acc[a][b] = zero16();
        gemm_mainloop<4>(acc, U, 4096, m0, W, 4096, n0, 4096, lds, pre);
        { const int tn = tile + gridDim.x; pre = tn < 128 * NTN; if (pre) { const int mtn = tn / NTN, ntn_ = tn % NTN; f32x16 (&dummy)[2][4] = acc; gemm_mainloop<4>(dummy, U, 4096, (mtn >> 5) * LP + OFF + (mtn & 31) * 256, W, 4096, ntn_ * 256, 4096, lds, false, true); } }
        const int col = n0 + wn * 128 + 4 * r;
        const size_t crow0 = (size_t)mt * 256 + wm * 64 + 4 * hh;
#pragma unroll
        for (int mb = 0; mb < 2; ++mb) {
#pragma unroll
          for (int hf = 0; hf < 2; ++hf) {
            f32x4 yv[16];
#pragma unroll
            for (int i = 8 * hf; i < 8 * hf + 8; ++i) yv[i] = *(const f32x4*)(P.out + O_Y + (crow0 + mb * 32 + (i & 3) + 8 * (i >> 2)) * 1024 + col);
#pragma unroll
            for (int i = 8 * hf; i < 8 * hf + 8; ++i) {
                f32x4 o = yv[i]; o.x += acc[mb][0][i]; o.y += acc[mb][1][i]; o.z += acc[mb][2][i]; o.w += acc[mb][3][i];
                __builtin_nontemporal_store(o, (f32x4*)(P.out + O_Y + (crow0 + mb * 32 + (i & 3) + 8 * (i >> 2)) * 1024 + col));
            }
          }
        }
    }
    {
        float* red = (float*)lds; float* c1 = (float*)(lds + 32768);
#pragma unroll 1
        for (int pc = blockIdx.x; pc < 8 * 32; pc += gridDim.x) {
            const int rg = pc >> 5, cg = pc & 31;
            small_tile(U, 4096, MPR + 32 * rg, W, 4096, 32 * cg, 4096, c1, red);
            const int rl = t >> 4, cl = (t & 15) * 2; const int srow = 32 * rg + rl, col = 32 * cg + cl;
            f32x2* yp = (f32x2*)(P.out + O_YS + (size_t)srow * 1024 + col);
            f32x2 yv = *yp; yv.x += c1[rl * 33 + cl]; yv.y += c1[rl * 33 + cl + 1]; *yp = yv;
            __syncthreads();
        }
    }
}

template <bool OUT>
DI void ret_chunk(const Params& P, unsigned char* lds, f32x16 (&S)[4], size_t row0, int CL, int head, float lg2_in) {
    float lg2 = lg2_in; asm volatile("" : "+v"(lg2));
    const int t = opaque_tid(), w = t >> 6, lane = t & 63, r = lane & 31, hh = lane >> 5;
    const bf16_t* RQ = (const bf16_t*)(P.ws + WS_RQ); const bf16_t* RK = (const bf16_t*)(P.ws + WS_RK); const bf16_t* RV = (const bf16_t*)(P.ws + WS_RV);
    bf16_t* RG = (bf16_t*)(P.ws + WS_RG);
    unsigned char* Qs = lds; unsigned char* Ks = lds + 17408; unsigned char* KTs = lds + 34816; unsigned char* VTs = lds + 53248; float* OUTs = (float*)(lds + 90112);
    {
        const int n = t & 63; const bool live = n < CL;
        const float kdec = ex2((float)(CL - 1 - n) * lg2);
#pragma unroll
        for (int i = 0; i < 2; ++i) {
            const int dc = (t >> 6) + 8 * i;
            u32x4 kv = (u32x4){0u, 0u, 0u, 0u};
            if (live) kv = *(const u32x4*)(RK + (row0 + n) * 512 + head * 128 + dc * 8);
            if (OUT) {
                u32x4 qv = (u32x4){0u, 0u, 0u, 0u};
                if (live) qv = *(const u32x4*)(RQ + (row0 + n) * 512 + head * 128 + dc * 8);
                *(u32x4*)(Qs + n * 272 + dc * 16) = qv; *(u32x4*)(Ks + n * 272 + dc * 16) = kv;
            }
#pragma unroll
            for (int e = 0; e < 4; ++e) {
                const unsigned u = kv[e];
                *(bf16_t*)(KTs + (dc * 8 + 2 * e) * 144 + n * 2) = f2bf(bflo(u) * kdec);
                *(bf16_t*)(KTs + (dc * 8 + 2 * e + 1) * 144 + n * 2) = f2bf(bfhi(u) * kdec);
            }
        }
#pragma unroll
        for (int i = 0; i < 4; ++i) {
            const int vc = (t >> 6) + 8 * i;
            u32x4 vv = (u32x4){0u, 0u, 0u, 0u};
            if (live) vv = *(const u32x4*)(RV + (row0 + n) * 1024 + head * 256 + vc * 8);
#pragma unroll
            for (int e = 0; e < 4; ++e) {
                const unsigned u = vv[e];
                *(bf16_t*)(VTs + (vc * 8 + 2 * e) * 144 + n * 2) = (bf16_t)(u & 0xffffu);
                *(bf16_t*)(VTs + (vc * 8 + 2 * e + 1) * 144 + n * 2) = (bf16_t)(u >> 16);
            }
        }
    }
    __syncthreads();
    __builtin_amdgcn_sched_barrier(0);
    if (OUT) {
        f32x16 o[2]; o[0] = zero16(); o[1] = zero16();
#pragma unroll
        for (int db = 0; db < 4; ++db)
#pragma unroll
            for (int sp = 0; sp < 2; ++sp) {
                const bf16x8 bs = pack8(S[db], sp);
#pragma unroll
                for (int nbo = 0; nbo < 2; ++nbo) {
                    const unsigned char* qa = Qs + (32 * nbo + r) * 272 + (32 * db + 16 * sp + 4 * hh) * 2;
                    const bf16x8 a = cat4(*(const s16x4*)qa, *(const s16x4*)(qa + 16));
                    o[nbo] = MFMA(a, bs, o[nbo]);
                }
            }
        __builtin_amdgcn_sched_barrier(0);
#pragma unroll
        for (int nbo = 0; nbo < 2; ++nbo)
#pragma unroll
            for (int i = 0; i < 16; ++i) o[nbo][i] *= ex2((float)(32 * nbo + crow(i, hh) + 1) * lg2);
        __builtin_amdgcn_sched_barrier(0);
#pragma unroll
        for (int tix = 0; tix < 3; ++tix) {
            const int mb = (tix == 2) ? 1 : 0, nb = (tix == 0) ? 0 : 1;
            __builtin_amdgcn_sched_barrier(0);
            f32x16 x = zero16();
#pragma unroll
            for (int s = 0; s < 8; ++s) {
                const bf16x8 a = *(const bf16x8*)(Ks + (32 * mb + r) * 272 + (16 * s + 8 * hh) * 2);
                const bf16x8 b = *(const bf16x8*)(Qs + (32 * nb + r) * 272 + (16 * s + 8 * hh) * 2);
                x = MFMA(a, b, x);
            }
#pragma unroll
            for (int i = 0; i < 16; ++i) {
                const int d = (32 * nb + r) - (32 * mb + crow(i, hh));
                x[i] = (d >= 0) ? x[i] * ex2((float)d * lg2) : 0.f;
            }
#pragma unroll
            for (int sp = 0; sp < 2; ++sp) {
                const bf16x8 xa = pack8(x, sp);
                const unsigned char* va = VTs + (32 * w + r) * 144 + (32 * mb + 16 * sp + 4 * hh) * 2;
                const bf16x8 b = cat4(*(const s16x4*)va, *(const s16x4*)(va + 16));
                o[nb] = MFMA(xa, b, o[nb]);
            }
        }
        __builtin_amdgcn_sched_barrier(0);
#pragma unroll
        for (int nb = 0; nb < 2; ++nb)
#pragma unroll
            for (int i = 0; i < 16; ++i) OUTs[(32 * nb + crow(i, hh)) * 260 + 32 * w + r] = o[nb][i];
        __builtin_amdgcn_sched_barrier(0);
    }
    {
        const float gC = ex2((float)CL * lg2);
#pragma unroll
        for (int db = 0; db < 4; ++db) S[db] = S[db] * gC;
#pragma unroll
        for (int s = 0; s < 4; ++s) {
            const bf16x8 b = *(const bf16x8*)(VTs + (32 * w + r) * 144 + (16 * s + 8 * hh) * 2);
#pragma unroll
            for (int db = 0; db < 4; ++db) {
                const bf16x8 a = *(const bf16x8*)(KTs + (32 * db + r) * 144 + (16 * s + 8 * hh) * 2);
                S[db] = MFMA(a, b, S[db]);
            }
        }
    }
    __syncthreads();
    __builtin_amdgcn_sched_barrier(0);
    if (OUT) {
        const int n = t >> 3, sg = t & 7;
        f32x4 xv[8]; float s1 = 0.f, s2 = 0.f;
#pragma unroll
        for (int j = 0; j < 8; ++j) {
            xv[j] = *(const f32x4*)(OUTs + n * 260 + sg * 32 + 4 * j);
            s1 += (xv[j].x + xv[j].y) + (xv[j].z + xv[j].w);
            s2 += (xv[j].x * xv[j].x + xv[j].y * xv[j].y) + (xv[j].z * xv[j].z + xv[j].w * xv[j].w);
        }
#pragma unroll
        for (int o = 1; o < 8; o <<= 1) { s1 += __shfl_xor(s1, o); s2 += __shfl_xor(s2, o); }
        const float mean = s1 * (1.f / 256.f); const float var = fmaxf(s2 * (1.f / 256.f) - mean * mean, 0.f);
        const float rstd = frsq(var + EPS);
        if (n < CL) {
            bf16_t* gp = RG + (row0 + n) * 1024 + head * 256 + sg * 32;
            const float* gn = P.ret_gn_g + head * 256 + sg * 32;
            u32x4 gu[4];
#pragma unroll
            for (int j = 0; j < 4; ++j) gu[j] = *(const u32x4*)(gp + 8 * j);
#pragma unroll
            for (int j = 0; j < 4; ++j) {
                const f32x4 g0 = *(const f32x4*)(gn + 8 * j), g1 = *(const f32x4*)(gn + 8 * j + 4);
                const f32x4 xa = xv[2 * j], xb = xv[2 * j + 1];
                float y[8], gt[8];
                gt[0] = bflo(gu[j].x); gt[1] = bfhi(gu[j].x); gt[2] = bflo(gu[j].y); gt[3] = bfhi(gu[j].y); gt[4] = bflo(gu[j].z); gt[5] = bfhi(gu[j].z); gt[6] = bflo(gu[j].w); gt[7] = bfhi(gu[j].w);
                y[0] = (xa.x - mean) * rstd * g0.x; y[1] = (xa.y - mean) * rstd * g0.y; y[2] = (xa.z - mean) * rstd * g0.z; y[3] = (xa.w - mean) * rstd * g0.w;
                y[4] = (xb.x - mean) * rstd * g1.x; y[5] = (xb.y - mean) * rstd * g1.y; y[6] = (xb.z - mean) * rstd * g1.z; y[7] = (xb.w - mean) * rstd * g1.w;
#pragma unroll
                for (int e = 0; e < 8; ++e) y[e] *= gt[e] * frcp(1.f + ex2(-LOG2E * gt[e]));
                u32x4 ou; ou.x = pk2(y[0], y[1]); ou.y = pk2(y[2], y[3]); ou.z = pk2(y[4], y[5]); ou.w = pk2(y[6], y[7]);
                *(u32x4*)(gp + 8 * j) = ou;
            }
        }
    }
}

DI float head_lg2(int head) { return log2f(1.f - 1.f / (float)(32 << head)); }

DI void ret_passA_item(const Params& P, unsigned char* lds, int item) {
    const int bh = item / 12, g = item % 12, b = bh >> 2, head = bh & 3;
    const int t = opaque_tid(), w = t >> 6, lane = t & 63;
    const float lg2 = head_lg2(head);
    f32x16 S[4];
#pragma unroll
    for (int db = 0; db < 4; ++db) S[db] = zero16();
#pragma unroll 1
    for (int c = 0; c < 10; ++c) ret_chunk<false>(P, lds, S, (size_t)b * LP + 640 * g + 64 * c, 64, head, lg2);
    float* T = (float*)(P.ws + WS_TG) + ((size_t)item * 8 + w) * 4096;
#pragma unroll
    for (int db = 0; db < 4; ++db)
#pragma unroll
        for (int i = 0; i < 16; ++i) T[(db * 16 + i) * 64 + lane] = S[db][i];
}

DI void ret_passC_prompt(const Params& P, unsigned char* lds, int bh, int g) {
    const int b = bh >> 2, head = bh & 3;
    const int t = opaque_tid(), w = t >> 6, lane = t & 63, r = lane & 31, hh = lane >> 5;
    const float lg2 = head_lg2(head);
    f32x16 S[4];
#pragma unroll
    for (int db = 0; db < 4; ++db) S[db] = zero16();
    const float g640 = ex2(640.f * lg2);
#pragma unroll 1
    for (int gp = 0; gp < g; ++gp) {
        const float* T = (const float*)(P.ws + WS_TG) + ((size_t)(bh * 12 + gp) * 8 + w) * 4096;
#pragma unroll
        for (int db = 0; db < 4; ++db)
#pragma unroll
            for (int i = 0; i < 16; ++i) S[db][i] = S[db][i] * g640 + T[(db * 16 + i) * 64 + lane];
    }
#pragma unroll 1
    for (int c = 0; c < 10; ++c) ret_chunk<true>(P, lds, S, (size_t)b * LP + 640 * g + 64 * c, 64, head, lg2);
    if (g == 12) {
        float* dst = P.out + O_PST + (size_t)bh * 32768;
#pragma unroll
        for (int db = 0; db < 4; ++db)
#pragma unroll
            for (int i = 0; i < 16; ++i) dst[(32 * db + crow(i, hh)) * 256 + 32 * w + r] = S[db][i];
    }
    __syncthreads();
}

DI void ret_sample_item(const Params& P, unsigned char* lds, int sb, int head) {
    const int t = opaque_tid(), w = t >> 6, lane = t & 63, r = lane & 31, hh = lane >> 5;
    const float lg2 = head_lg2(head);
    const float* src = P.state_ret + (size_t)(sb * 4 + head) * 32768;
    f32x16 S[4];
#pragma unroll
    for (int db = 0; db < 4; ++db)
#pragma unroll
        for (int i = 0; i < 16; ++i) S[db][i] = src[(32 * db + crow(i, hh)) * 256 + 32 * w + r];
    ret_chunk<true>(P, lds, S, (size_t)MPR + sb * 32, 32, head, lg2);
    float* dst = P.out + O_SST + (size_t)(sb * 4 + head) * 32768;
#pragma unroll
    for (int db = 0; db < 4; ++db)
#pragma unroll
        for (int i = 0; i < 16; ++i) dst[(32 * db + crow(i, hh)) * 256 + 32 * w + r] = S[db][i];
    __syncthreads();
}

DI double wave_incl_scan(double v, int lane) {
#pragma unroll
    for (int o = 1; o < 64; o <<= 1) { const double u = __shfl_up(v, o); if (lane >= o) v += u; }
    return v;
}
DI void cumsum_seq(const Params& P, int seq, int lane) {
    if (seq < 32) {
        const int b = seq >> 3, h = seq & 7;
        const float* lf = (const float*)(P.ws + WS_LOGF) + (size_t)b * LP * 8 + h;
        float* nck = (float*)(P.ws + WS_NCKP) + (size_t)seq * LP;
        double loc = 0.0;
#pragma unroll 1
        for (int bt = 0; bt < 5; ++bt) {
            float v[26];
#pragma unroll
            for (int j = 0; j < 26; ++j) v[j] = lf[(size_t)(130 * lane + 26 * bt + j) * 8];
#pragma unroll
            for (int j = 0; j < 26; ++j) loc += (double)v[j];
        }
        const double inc = wave_incl_scan(loc, lane);
        double run = inc - loc;
#pragma unroll 1
        for (int bt = 0; bt < 5; ++bt) {
            float v[26];
#pragma unroll
            for (int j = 0; j < 26; ++j) v[j] = lf[(size_t)(130 * lane + 26 * bt + j) * 8];
#pragma unroll
            for (int j = 0; j < 26; ++j) { const int p = 130 * lane + 26 * bt + j; run += (double)v[j]; nck[p] = (p < VAL0) ? -1e30f : -(float)run; }
        }
    } else {
        const int s = seq - 32, sb = s >> 3, h = s & 7;
        const float* cl = P.cache_logf + (size_t)sb * 4096 * 8 + h;
        float* nck = (float*)(P.ws + WS_NCKS) + (size_t)s * 4128;
        double loc = 0.0;
#pragma unroll 1
        for (int bt = 0; bt < 4; ++bt) {
            float v[16];
#pragma unroll
            for (int j = 0; j < 16; ++j) v[j] = cl[(size_t)(64 * lane + 16 * bt + j) * 8];
#pragma unroll
            for (int j = 0; j < 16; ++j) loc += (double)v[j];
        }
        const double inc = wave_incl_scan(loc, lane);
        double run = inc - loc;
#pragma unroll 1
        for (int bt = 0; bt < 4; ++bt) {
            float v[16];
#pragma unroll
            for (int j = 0; j < 16; ++j) v[j] = cl[(size_t)(64 * lane + 16 * bt + j) * 8];
#pragma unroll
            for (int j = 0; j < 16; ++j) { const int p = 64 * lane + 16 * bt + j; run += (double)v[j]; nck[p] = -(float)run; }
        }
        const double tot = __shfl(inc, 63);
        const float* lf = (const float*)(P.ws + WS_LOGF) + ((size_t)MPR + sb * 32) * 8 + h;
        const double mine = (lane < 32) ? (double)lf[(size_t)lane * 8] : 0.0;
        const double inc2 = wave_incl_scan(mine, lane);
        if (lane < 32) nck[4096 + lane] = -(float)(tot + inc2);
    }
}

DI void phase_p2(const Params& P, unsigned char* lds) {
    constexpr int NRET = 192, NCUM = 12;
    for (int it = blockIdx.x; it < NRET + NCUM; it += gridDim.x) {
        if (it < NRET) { ret_passA_item(P, lds, it); __syncthreads(); }
        else { const int seq = (it - NRET) * 8 + (threadIdx.x >> 6); cumsum_seq(P, seq, threadIdx.x & 63); }
    }
}

DI void attn_prompt_item(const Params& P, unsigned char* lds, int b, int head, int qb, float qkb2) {
    const int t = opaque_tid(), w = t >> 6, lane = t & 63, r = lane & 31, hh = lane >> 5;
    const bf16_t* FK = (const bf16_t*)(P.ws + WS_FK); const bf16_t* VT = (const bf16_t*)(P.ws + WS_VT); bf16_t* FQ = (bf16_t*)(P.ws + WS_FQ);
    const float* NCK = (const float*)(P.ws + WS_NCKP) + (size_t)(b * 8 + head) * LP;
    const int q0 = OFF + 256 * qb, qw0 = q0 + 32 * w, myq = qw0 + r;
    const float cref = -NCK[q0];
    bf16_t* qp = FQ + ((size_t)b * LP + myq) * 1024 + head * 128;
    bf16x8 qf[8];
#pragma unroll
    for (int s = 0; s < 8; ++s) qf[s] = *(const bf16x8*)(qp + 16 * s + 8 * hh);
    f32x16 o[4];
#pragma unroll
    for (int db = 0; db < 4; ++db) o[db] = zero16();
    float m_run = -1e30f, l_run = 0.f;
    const int kt_last = (q0 + 255) >> 6;
    constexpr int BUF = 36864, VOFF = 17408, BOFF = 35840, WMOFF = 3 * BUF;
    const int kkey = t >> 4, kdc = t & 15;
    const int vd = t >> 3, vkc = t & 7;
    const bf16_t* kg = FK + ((size_t)b * LP + kkey) * 1024 + head * 128 + kdc * 8;
    const bf16_t* vg = VT + ((size_t)((b * 8 + head) * 128 + vd)) * LP + vkc * 8;
    u32x4 kr[2], vr[2]; float br = 0.f;
#define ATT_GLOAD(KT) do { const int kbase_ = (KT) * 64; \
        kr[0] = *(const u32x4*)(kg + (size_t)kbase_ * 1024); kr[1] = *(const u32x4*)(kg + (size_t)(kbase_ + 32) * 1024); \
        vr[0] = *(const u32x4*)(vg + kbase_); vr[1] = *(const u32x4*)(vg + (size_t)64 * LP + kbase_); \
        if (t < 64) br = (NCK[kbase_ + t] + cref) * LOG2E; } while (0)
#define ATT_SWRITE(BI) do { unsigned char* sb_ = lds + (BI) * BUF; \
        *(u32x4*)(sb_ + kkey * 272 + kdc * 16) = kr[0]; *(u32x4*)(sb_ + (kkey + 32) * 272 + kdc * 16) = kr[1]; \
        *(u32x4*)(sb_ + VOFF + vd * 144 + vkc * 16) = vr[0]; *(u32x4*)(sb_ + VOFF + (vd + 64) * 144 + vkc * 16) = vr[1]; \
        if (t < 64) *(float*)(sb_ + BOFF + t * 4) = br; } while (0)
#define ATT_PV(SBV, PP) do { _Pragma("unroll") for (int kb_ = 0; kb_ < 2; ++kb_) _Pragma("unroll") for (int sp_ = 0; sp_ < 2; ++sp_) _Pragma("unroll") for (int db_ = 0; db_ < 4; ++db_) { \
        const unsigned char* va_ = (SBV) + VOFF + (32 * db_ + r) * 144 + (32 * kb_ + 16 * sp_ + 4 * hh) * 2; \
        o[db_] = MFMA(cat4(*(const s16x4*)va_, *(const s16x4*)(va_ + 16)), PP[kb_][sp_], o[db_]); } } while (0)
    float* WM = (float*)(lds + WMOFF);
    if (t < 16) WM[t] = -1e30f;
    ATT_GLOAD(kt_last); ATT_SWRITE(kt_last % 3);
    __syncthreads();
    const bool late = __builtin_amdgcn_readfirstlane(w) >= 4;
    bf16x8 pp[2][2]; bool pending = false; int pbuf = 0;
#pragma unroll 1
    for (int kt = kt_last; kt >= 1; --kt) {
        const int bi = kt % 3;
        const unsigned char* sb = lds + bi * BUF;
        {
            const f32x4 w0 = *(const f32x4*)(WM + ((kt + 1) & 1) * 8), w1 = *(const f32x4*)(WM + ((kt + 1) & 1) * 8 + 4);
            const float mfloor = fminf(fminf(fminf(w0.x, w0.y), fminf(w0.z, w0.w)), fminf(fminf(w1.x, w1.y), fminf(w1.z, w1.w)));
            const float blast = *(const float*)(sb + BOFF + 63 * 4);
            if (blast + qkb2 < mfloor - 32.f) break;
        }
        const bool more = kt > 1;
        if (more) ATT_GLOAD(kt - 1);
        if (pending) { ATT_PV(lds + pbuf * BUF, pp); pending = false; }
        float wmin = -1e30f;
        if (kt * 64 <= qw0 + 31) {
            f32x16 st[2];
#pragma unroll
            for (int kb = 0; kb < 2; ++kb) {
                st[kb] = zero16();
#pragma unroll
                for (int s = 0; s < 8; ++s) {
                    const bf16x8 a = *(const bf16x8*)(sb + (32 * kb + r) * 272 + (16 * s + 8 * hh) * 2);
                    st[kb] = MFMA(a, qf[s], st[kb]);
                }
            }
            const bool need_mask = (kt * 64 + 63 > qw0);
            float mx = -1e30f;
#pragma unroll
            for (int kb = 0; kb < 2; ++kb)
#pragma unroll
                for (int g = 0; g < 4; ++g) {
                    const f32x4 bz = *(const f32x4*)(sb + BOFF + (32 * kb + 8 * g + 4 * hh) * 4);
#pragma unroll
                    for (int e = 0; e < 4; ++e) {
                        float v = st[kb][4 * g + e] * ATT_SC + bz[e];
                        if (need_mask) { const int key = kt * 64 + 32 * kb + 8 * g + 4 * hh + e; v = (key > myq) ? -1e30f : v; }
                        st[kb][4 * g + e] = v; mx = fmaxf(mx, v);
                    }
                }
            mx = fmaxf(mx, __shfl_xor(mx, 32));
            const float m_new = fmaxf(m_run, mx);
            const bool grew = __builtin_amdgcn_ballot_w64(m_new > m_run) != 0ull;
            float ps = 0.f;
#pragma unroll
            for (int kb = 0; kb < 2; ++kb)
#pragma unroll
                for (int i = 0; i < 16; ++i) { const float pv = ex2(st[kb][i] - m_new); st[kb][i] = pv; ps += pv; }
            if (grew) {
                const float alpha = ex2(m_run - m_new); m_run = m_new;
                l_run = l_run * alpha;
#pragma unroll
                for (int db = 0; db < 4; ++db) o[db] = o[db] * alpha;
            }
            l_run += ps;
#pragma unroll
            for (int kb = 0; kb < 2; ++kb)
#pragma unroll
                for (int sp = 0; sp < 2; ++sp) pp[kb][sp] = pack8(st[kb], sp);
            if (late) { pending = true; pbuf = bi; }
            else ATT_PV(sb, pp);
            wmin = m_run;
#pragma unroll
            for (int of = 1; of < 32; of <<= 1) wmin = fminf(wmin, __shfl_xor(wmin, of));
        }
        if (lane == 0) WM[(kt & 1) * 8 + w] = wmin;
        if (more) ATT_SWRITE((kt - 1) % 3);
        __syncthreads();
    }
    if (pending) ATT_PV(lds + pbuf * BUF, pp);
#undef ATT_GLOAD
#undef ATT_SWRITE
#undef ATT_PV
    const float lt = l_run + __shfl_xor(l_run, 32);
    const float inv = frcp(lt);
#pragma unroll
    for (int db = 0; db < 4; ++db)
#pragma unroll
        for (int g = 0; g < 4; ++g) {
            u32x2 ov; ov.x = pk2(o[db][4 * g] * inv, o[db][4 * g + 1] * inv); ov.y = pk2(o[db][4 * g + 2] * inv, o[db][4 * g + 3] * inv);
            *(u32x2*)(qp + 32 * db + 8 * g + 4 * hh) = ov;
        }
}

DI void attn_sample_item(const Params& P, unsigned char* lds, int sb, int head) {
    const int t = opaque_tid(), w = t >> 6, lane = t & 63, r = lane & 31, hh = lane >> 5;
    bf16_t* FQ = (bf16_t*)(P.ws + WS_FQ);
    const float* NCK = (const float*)(P.ws + WS_NCKS) + (size_t)(sb * 8 + head) * 4128;
    const float cref = -NCK[4096];
    bf16_t* qrow = FQ + ((size_t)MPR + sb * 32) * 1024 + head * 128;
    bf16x8 qf[8];
#pragma unroll
    for (int s = 0; s < 8; ++s) qf[s] = *(const bf16x8*)(qrow + (size_t)r * 1024 + 16 * s + 8 * hh);
    f32x16 o[4];
#pragma unroll
    for (int db = 0; db < 4; ++db) o[db] = zero16();
    float m_run = -1e30f, l_run = 0.f;
#pragma unroll 1
    for (int tile = w; tile < 129; tile += 8) {
        const float *kbase, *vbase;
        if (tile < 128) { const size_t off = ((size_t)sb * 4096 + 32 * tile) * 1024 + head * 128; kbase = P.cache_k + off; vbase = P.cache_v + off; }
        else { const size_t off = (size_t)sb * 32 * 1024 + head * 128; kbase = P.out + O_SK + off; vbase = P.out + O_SV + off; }
        f32x16 st = zero16();
#pragma unroll
        for (int s = 0; s < 8; ++s) {
            const float* kp = kbase + (size_t)r * 1024 + 16 * s + 8 * hh;
            const f32x4 k0 = *(const f32x4*)kp, k1 = *(const f32x4*)(kp + 4);
            u32x4 pk; pk.x = pk2(k0.x, k0.y); pk.y = pk2(k0.z, k0.w); pk.z = pk2(k1.x, k1.y); pk.w = pk2(k1.z, k1.w);
            st = MFMA(__builtin_bit_cast(bf16x8, pk), qf[s], st);
        }
        float mx = -1e30f;
#pragma unroll
        for (int g = 0; g < 4; ++g) {
            const f32x4 bz = *(const f32x4*)(NCK + 32 * tile + 8 * g + 4 * hh);
#pragma unroll
            for (int e = 0; e < 4; ++e) {
                float v = st[4 * g + e] * ATT_SC + (bz[e] + cref) * LOG2E;
                if (tile == 128) { const int key = 8 * g + 4 * hh + e; v = (key > r) ? -1e30f : v; }
                st[4 * g + e] = v; mx = fmaxf(mx, v);
            }
        }
        mx = fmaxf(mx, __shfl_xor(mx, 32));
        const float m_new = fmaxf(m_run, mx);
        const float alpha = ex2(m_run - m_new); m_run = m_new;
        float ps = 0.f;
#pragma unroll
        for (int i = 0; i < 16; ++i) { const float pv = ex2(st[i] - m_new); st[i] = pv; ps += pv; }
        l_run = l_run * alpha + ps;
#pragma unroll
        for (int db = 0; db < 4; ++db) o[db] = o[db] * alpha;
#pragma unroll
        for (int sp = 0; sp < 2; ++sp) {
            const bf16x8 pb = pack8(st, sp);
#pragma unroll
            for (int db = 0; db < 4; ++db) {
                const float* vp = vbase + (size_t)(16 * sp + 4 * hh) * 1024 + 32 * db + r;
                float f[8];
#pragma unroll
                for (int j = 0; j < 8; ++j) f[j] = vp[(size_t)((j & 3) + 8 * (j >> 2)) * 1024];
                u32x4 pk; pk.x = pk2(f[0], f[1]); pk.y = pk2(f[2], f[3]); pk.z = pk2(f[4], f[5]); pk.w = pk2(f[6], f[7]);
                o[db] = MFMA(__builtin_bit_cast(bf16x8, pk), pb, o[db]);
            }
        }
    }
    const float lt = l_run + __shfl_xor(l_run, 32);
    float* Ol = (float*)lds; float* ML = (float*)(lds + 131072);
#pragma unroll
    for (int db = 0; db < 4; ++db)
#pragma unroll
        for (int i = 0; i < 16; ++i) Ol[(w * 128 + 32 * db + crow(i, hh)) * 32 + r] = o[db][i];
    if (hh == 0) { ML[(w * 32 + r) * 2] = m_run; ML[(w * 32 + r) * 2 + 1] = lt; }
    __syncthreads();
    {
        const int q = t & 31, dg = t >> 5;
        float M = -1e30f;
#pragma unroll
        for (int ww = 0; ww < 8; ++ww) M = fmaxf(M, ML[(ww * 32 + q) * 2]);
        float L = 0.f, a[8];
#pragma unroll
        for (int e = 0; e < 8; ++e) a[e] = 0.f;
#pragma unroll
        for (int ww = 0; ww < 8; ++ww) {
            const float f = ex2(ML[(ww * 32 + q) * 2] - M); L += ML[(ww * 32 + q) * 2 + 1] * f;
#pragma unroll
            for (int e = 0; e < 8; ++e) a[e] += Ol[(ww * 128 + dg * 8 + e) * 32 + q] * f;
        }
        const float inv = frcp(L);
        u32x4 ov; ov.x = pk2(a[0] * inv, a[1] * inv); ov.y = pk2(a[2] * inv, a[3] * inv); ov.z = pk2(a[4] * inv, a[5] * inv); ov.w = pk2(a[6] * inv, a[7] * inv);
        *(u32x4*)(qrow + (size_t)q * 1024 + dg * 8) = ov;
    }
    __syncthreads();
}

DI void phase_p3(const Params& P, unsigned char* lds) {
    constexpr int N_RETP = 208, N_RETS = 32, N_AS = 64, N_AP = 1024;
    constexpr int NITEMS = N_RETP + N_RETS + N_AS + N_AP;
    int* s_item = (int*)(lds + LDS_BYTES - 16);
    unsigned* ctr = (unsigned*)(P.ws + WS_CTL);
    float qkb2;
    {
        const int lane = threadIdx.x & 63;
        float gq = fmaxf(fabsf(P.q_norm_g[lane]), fabsf(P.q_norm_g[lane + 64])), gk = fmaxf(fabsf(P.k_norm_g[lane]), fabsf(P.k_norm_g[lane + 64]));
#pragma unroll
        for (int o = 1; o < 64; o <<= 1) { gq = fmaxf(gq, __shfl_xor(gq, o)); gk = fmaxf(gk, __shfl_xor(gk, o)); }
        qkb2 = 128.f * gq * gk * 1.02f * ATT_SC;
    }
    for (;;) {
        if (threadIdx.x == 0) *s_item = (int)atomicAdd(ctr, 1u);
        __syncthreads();
        int it = *s_item;
        __syncthreads();
        if (it >= NITEMS) break;
        if (it < 256) { const int head = 7 - (it >> 7), rem = it & 127; attn_prompt_item(P, lds, rem & 3, head, 31 - (rem >> 2), qkb2); continue; } it -= 256;
        if (it < N_RETP) { ret_passC_prompt(P, lds, it / 13, it % 13); continue; } it -= N_RETP;
        if (it < N_RETS) { ret_sample_item(P, lds, it >> 2, it & 3); continue; } it -= N_RETS;
        if (it < N_AS) { attn_sample_item(P, lds, it >> 3, it & 7); continue; } it -= N_AS;
        { const int head = 5 - (it >> 7), rem = it & 127; attn_prompt_item(P, lds, rem & 3, head, 31 - (rem >> 2), qkb2); }
    }
}

DI void light_grid_barrier(unsigned* ctl, unsigned seam) {
    asm volatile("s_waitcnt vmcnt(0)" ::: "memory");
    __syncthreads();
    if (threadIdx.x == 0) {
        const unsigned g = blockIdx.x & 7u, gs = (gridDim.x - g + 7u) >> 3, ng = gridDim.x < 8u ? gridDim.x : 8u;
        __builtin_amdgcn_fence(__ATOMIC_RELEASE, "agent");
        asm volatile("s_waitcnt vmcnt(0)" ::: "memory");
        const unsigned old = __hip_atomic_fetch_add(ctl + 64 + 32 * g, 1u, __ATOMIC_RELAXED, __HIP_MEMORY_SCOPE_AGENT);
        if (old == seam * gs + gs - 1u) {
            __builtin_amdgcn_fence(__ATOMIC_ACQ_REL, "agent");
            asm volatile("s_waitcnt vmcnt(0)" ::: "memory");
            const unsigned oldt = __hip_atomic_fetch_add(ctl + 32, 1u, __ATOMIC_RELAXED, __HIP_MEMORY_SCOPE_AGENT);
            if (oldt == seam * ng + ng - 1u) {
                __builtin_amdgcn_fence(__ATOMIC_ACQ_REL, "agent");
                asm volatile("s_waitcnt vmcnt(0)" ::: "memory");
                for (unsigned j = 0; j < ng; ++j) __hip_atomic_store(ctl + 320 + 32 * j, seam + 1u, __ATOMIC_RELAXED, __HIP_MEMORY_SCOPE_AGENT);
            }
        }
        while (__hip_atomic_load(ctl + 320 + 32 * g, __ATOMIC_RELAXED, __HIP_MEMORY_SCOPE_AGENT) < seam + 1u) __builtin_amdgcn_s_sleep(8);
        __builtin_amdgcn_fence(__ATOMIC_ACQUIRE, "agent");
        asm volatile("s_waitcnt vmcnt(0)" ::: "memory");
    }
    __syncthreads();
}

#define XB_TMO      128
#define XB_XCNT(j)  (256  + 64 * (j))
#define XB_XSUB(j)  (1280 + 64 * (j))
#define XB_XGEN(j)  (2304 + 64 * (j))
#define XB_TOP      3328
#define XB_TOPGEN   3392
#define XB_SPIN_CAP (1u << 18)
DI unsigned xb_ld(unsigned* p)              { return __hip_atomic_load(p, __ATOMIC_RELAXED, __HIP_MEMORY_SCOPE_AGENT); }
DI unsigned xb_add(unsigned* p, unsigned v) { return __hip_atomic_fetch_add(p, v, __ATOMIC_RELAXED, __HIP_MEMORY_SCOPE_AGENT); }
DI unsigned xb_xcc_id() { return (unsigned)__builtin_amdgcn_s_getreg((3 << 11) | 20) & 0xFu; }
#define XB_SPIN(cond, bar) do { unsigned _sp = 0; while (cond) { __builtin_amdgcn_s_sleep(1); \
    if ((++_sp & 255u) == 0u) { if (xb_ld(&(bar)[XB_TMO])) break; if (_sp > XB_SPIN_CAP) { atomicAdd(&(bar)[XB_TMO], 1u); break; } } } } while (0)
struct XcdBarrier { unsigned* bar; unsigned x; volatile AS_LDS unsigned* st; };
DI XcdBarrier xcd_barrier_post(unsigned* bar, volatile AS_LDS unsigned* st) {
    XcdBarrier b; b.bar = bar; b.x = xb_xcc_id(); b.st = st;
    if (threadIdx.x == 0) (void)xb_add(&bar[XB_XCNT(b.x)], 1u);
    return b;
}
DI void xcd_barrier_complete(unsigned* bar, unsigned x, unsigned& nloc, unsigned& nx) {
    const unsigned G = gridDim.x * gridDim.y * gridDim.z;
    unsigned sum, cnt, mine, sp = 0u;
    for (;;) {
        sum = 0u; cnt = 0u; mine = 0u;
#pragma unroll
        for (unsigned j = 0; j < 16; ++j) { const unsigned c = xb_ld(&bar[XB_XCNT(j)]); sum += c; cnt += (c > 0u) ? 1u : 0u; mine = (j == x) ? c : mine; }
        if (sum == G) break;
        __builtin_amdgcn_s_sleep(1);
        if ((++sp & 255u) == 0u) { if (xb_ld(&bar[XB_TMO])) break; if (sp > XB_SPIN_CAP) { atomicAdd(&bar[XB_TMO], 1u); break; } }
    }
    nloc = mine > 0u ? mine : 1u; nx = cnt > 0u ? cnt : 1u;
}
DI void xcd_barrier(const XcdBarrier& b) {
    asm volatile("s_waitcnt vmcnt(0)" ::: "memory");
    __syncthreads();
    if (threadIdx.x == 0) {
        unsigned* bar = b.bar;
        __builtin_amdgcn_s_waitcnt(0);
        unsigned nloc = b.st[0], nx = b.st[1];
        if (nloc == 0u) { xcd_barrier_complete(bar, b.x, nloc, nx); b.st[0] = nloc; b.st[1] = nx; }
        const unsigned old = xb_add(&bar[XB_XSUB(b.x)], 1u);
        const unsigned gen = old / nloc;
        if (old + 1u == (gen + 1u) * nloc) {
            __builtin_amdgcn_fence(__ATOMIC_RELEASE, "agent");
            asm volatile("s_waitcnt vmcnt(0)" ::: "memory");
            const unsigned og = xb_add(&bar[XB_TOP], 1u);
            const unsigned tg = og / nx;
            if (og + 1u == (tg + 1u) * nx) xb_add(&bar[XB_TOPGEN], 1u);
            else XB_SPIN(xb_ld(&bar[XB_TOPGEN]) == tg, bar);
            __builtin_amdgcn_fence(__ATOMIC_ACQUIRE, "agent");
            xb_add(&bar[XB_XGEN(b.x)], 1u);
            asm volatile("s_waitcnt vmcnt(0)" ::: "memory");
        } else {
            XB_SPIN(xb_ld(&bar[XB_XGEN(b.x)]) == gen, bar);
            __builtin_amdgcn_fence(__ATOMIC_ACQUIRE, "agent");
            asm volatile("s_waitcnt vmcnt(0)" ::: "memory");
        }
    }
    __syncthreads();
}

__global__ void __launch_bounds__(512) mega_fwd(Params P) {
    extern __shared__ __attribute__((aligned(16))) unsigned char lds[];
    cg::grid_group grid = cg::this_grid();
    volatile AS_LDS unsigned* xst = (volatile AS_LDS unsigned*)(lds + LDS_BYTES - 32);
    if (threadIdx.x < 2) xst[threadIdx.x] = 0u;
    __syncthreads();
    const XcdBarrier xb = xcd_barrier_post((unsigned*)(P.ws + WS_BAR), xst);
#define RUN_PHASE(K, BODY) do { if (P.ph_lo <= (K) && (K) < P.ph_hi) { BODY; if (P.coop && (K) + 1 < P.ph_hi) { if (P.pad) grid.sync();     xcd_barrier(xb); } } } while (0)
    RUN_PHASE(0, (p0_rows(P, lds), p0_weights(P, lds), p0_misc(P)));
    RUN_PHASE(1, phase_p1(P, lds));
    RUN_PHASE(2, phase_p2(P, lds));
    RUN_PHASE(3, phase_p3(P, lds));
    RUN_PHASE(4, phase_p4(P, lds));
    RUN_PHASE(5, phase_p5(P, lds));
    RUN_PHASE(6, phase_p6(P, lds));
    RUN_PHASE(7, phase_p7(P, lds));
#undef RUN_PHASE
}

extern "C" void kernel_launch(void* const* d_in, const int* in_sizes, int n_in, void* d_out, int out_size, void* d_ws, size_t ws_size, hipStream_t stream) {
    static int grid_blocks = 0;
    if (!grid_blocks) {
        int dev = 0, cus = 0, per_cu = 0;
        (void)hipGetDevice(&dev);
        (void)hipDeviceGetAttribute(&cus, hipDeviceAttributeMultiprocessorCount, dev);
        (void)hipFuncSetAttribute((const void*)mega_fwd, hipFuncAttributeMaxDynamicSharedMemorySize, LDS_BYTES);
        (void)hipOccupancyMaxActiveBlocksPerMultiprocessor(&per_cu, (const void*)mega_fwd, 512, LDS_BYTES);
        if (per_cu < 1) { fprintf(stderr, "kernel_launch: occupancy query returned %d\n", per_cu); per_cu = 1; }
        grid_blocks = cus * per_cu;
        if (ws_size < WS_END) fprintf(stderr, "kernel_launch: workspace too small: %zu < %zu\n", ws_size, (size_t)WS_END);
        (void)hipGetLastError();
    }
    Params p{};
    p.x_prompt = (const float*)d_in[0]; p.x_sample = (const float*)d_in[1]; p.state_ret = (const float*)d_in[2]; p.cache_k = (const float*)d_in[3];
    p.cache_v = (const float*)d_in[4]; p.cache_logf = (const float*)d_in[5]; p.meta = (const float*)d_in[6]; p.norm1_g = (const float*)d_in[7];
    p.w_in = (const float*)d_in[8]; p.b_forget = (const float*)d_in[9]; p.q_norm_g = (const float*)d_in[10]; p.k_norm_g = (const float*)d_in[11];
    p.ret_gn_g = (const float*)d_in[12]; p.w_ret_out = (const float*)d_in[13]; p.w_fox_out = (const float*)d_in[14]; p.w_o = (const float*)d_in[15];
    p.norm2_g = (const float*)d_in[16]; p.w_ff1 = (const float*)d_in[17]; p.w_ff2 = (const float*)d_in[18];
    p.out = (float*)d_out; p.ws = (unsigned char*)d_ws; p.pad = 0;
    (void)hipMemsetAsync((unsigned char*)d_ws + WS_BAR, 0, 16384, stream);
    (void)hipMemsetAsync((unsigned char*)d_ws + WS_CTL, 0, 4096, stream);
#if MULTI_LAUNCH
    for (int ph = 0; ph < 8; ++ph) {
        p.ph_lo = ph; p.ph_hi = ph + 1; p.coop = 0;
        hipLaunchKernelGGL(mega_fwd, dim3(grid_blocks), dim3(512), LDS_BYTES, stream, p);
    }
#else
    p.ph_lo = 0; p.ph_hi = 8; p.coop = 1;
    void* args[] = {&p};
    hipError_t e = hipLaunchCooperativeKernel((void*)mega_fwd, dim3(grid_blocks), dim3(512), args, LDS_BYTES, stream);
    if (e != hipSuccess) fprintf(stderr, "cooperative launch failed: %s (grid %d)\n", hipGetErrorString(e), grid_blocks);
#endif
}
```

```cpp
#include <hip/hip_runtime.h>
#include <hip/hip_cooperative_groups.h>
#include <cstdio>
#include <cstdint>
namespace cg = cooperative_groups;

#ifndef MULTI_LAUNCH
#define MULTI_LAUNCH 0
#endif

typedef short bf16x8 __attribute__((ext_vector_type(8)));
typedef short s16x4 __attribute__((ext_vector_type(4)));
typedef float f32x16 __attribute__((ext_vector_type(16)));
typedef float f32x4 __attribute__((ext_vector_type(4)));
typedef float f32x2 __attribute__((ext_vector_type(2)));
typedef unsigned u32x4 __attribute__((ext_vector_type(4)));
typedef unsigned u32x2 __attribute__((ext_vector_type(2)));
typedef __bf16 bf2_t __attribute__((ext_vector_type(2)));
typedef unsigned short bf16_t;
#define DI __device__ __forceinline__
#define MFMA(a, b, c) __builtin_amdgcn_mfma_f32_32x32x16_bf16((a), (b), (c), 0, 0, 0)

constexpr int D = 1024, LP = 8320, OFF = 128, VAL0 = 112, MPR = 33280, MT = 33536, INW = 8200, DFF = 4096;
constexpr int NTM = MT / 256;
constexpr float EPS = 1e-6f, LOG2E = 1.4426950408889634f;
constexpr float ATT_SC = 0.08838834764831845f * 1.4426950408889634f;
constexpr int LDS_BYTES = 163840;

constexpr size_t SZ_ACT = (size_t)MT * 1024 * 2;
constexpr size_t WS_CTL = 0;
constexpr size_t WS_BAR = 4096;
constexpr size_t WS_XN = 4096 + 16384;
constexpr size_t WS_WIN = WS_XN + SZ_ACT;
constexpr size_t WS_WRET = WS_WIN + (size_t)8192 * 1024 * 2;
constexpr size_t WS_WFOX = WS_WRET + 2097152;
constexpr size_t WS_WO = WS_WFOX + 2097152;
constexpr size_t WS_WFF1 = WS_WO + 2097152;
constexpr size_t WS_WFF2 = WS_WFF1 + 8388608;
constexpr size_t WS_RQ = WS_WFF2 + 8388608;
constexpr size_t WS_RK = WS_RQ + SZ_ACT / 2;
constexpr size_t WS_RV = WS_RK + SZ_ACT / 2;
constexpr size_t WS_RG = WS_RV + SZ_ACT;
constexpr size_t WS_FQ = WS_RG + SZ_ACT;
constexpr size_t WS_FK = WS_FQ + SZ_ACT;
constexpr size_t WS_VT = WS_FK + SZ_ACT;
constexpr size_t WS_LOGF = WS_VT + (size_t)4 * 8 * 128 * LP * 2;
constexpr size_t WS_NCKP = WS_LOGF + (size_t)MT * 8 * 4;
constexpr size_t WS_NCKS = WS_NCKP + (size_t)32 * LP * 4;
constexpr size_t WS_ROPE = WS_NCKS + (size_t)64 * 4128 * 4;
constexpr size_t WS_SSQ = WS_ROPE + (size_t)LP * 64 * 8;
constexpr size_t WS_GAS = WS_SSQ + (size_t)MT * 8 * 4;
constexpr size_t WS_GBS = WS_GAS + 524288;
constexpr size_t WS_SSQS = WS_GBS + 524288;
constexpr size_t WS_END = WS_SSQS + 32768;
constexpr size_t WS_TG = WS_XN;
constexpr size_t WS_M = WS_RV;
constexpr size_t WS_A2 = WS_FK;
constexpr size_t WS_U = WS_RQ;
static_assert(WS_END <= (size_t)512 * 1024 * 1024, "workspace too large");
static_assert(WS_U + (size_t)MT * 4096 * 2 == WS_FK, "U alias");

constexpr size_t O_Y = 0, O_YS = 33554432, O_PST = O_YS + 262144, O_PK = O_PST + 524288, O_PV = O_PK + 33619968, O_PLF = O_PV + 33619968,
                 O_SST = O_PLF + 262656, O_SK = O_SST + 1048576, O_SV = O_SK + 262144, O_SLF = O_SV + 262144;

struct Params {
    const float* x_prompt; const float* x_sample; const float* state_ret; const float* cache_k; const float* cache_v; const float* cache_logf;
    const float* meta; const float* norm1_g; const float* w_in; const float* b_forget; const float* q_norm_g; const float* k_norm_g; const float* ret_gn_g;
    const float* w_ret_out; const float* w_fox_out; const float* w_o; const float* norm2_g; const float* w_ff1; const float* w_ff2;
    float* out; unsigned char* ws; int ph_lo, ph_hi, coop, pad;
};

DI unsigned pk2(float a, float b) { f32x2 v = {a, b}; bf2_t r = __builtin_convertvector(v, bf2_t); return __builtin_bit_cast(unsigned, r); }
DI bf16_t f2bf(float a) { return (bf16_t)(pk2(a, 0.f) & 0xffffu); }
DI float bflo(unsigned u) { return __uint_as_float(u << 16); }
DI float bfhi(unsigned u) { return __uint_as_float(u & 0xffff0000u); }
DI float bf2f(bf16_t u) { return __uint_as_float(((unsigned)u) << 16); }
DI int crow(int i, int h) { return (i & 3) + 8 * (i >> 2) + 4 * h; }
DI float ex2(float x) { return __builtin_amdgcn_exp2f(x); }
DI float frcp(float x) { return __builtin_amdgcn_rcpf(x); }
DI float frsq(float x) { return __builtin_amdgcn_rsqf(x); }
DI bf16x8 pack8(const f32x16& x, int s) {
    u32x4 p; p.x = pk2(x[8 * s], x[8 * s + 1]); p.y = pk2(x[8 * s + 2], x[8 * s + 3]); p.z = pk2(x[8 * s + 4], x[8 * s + 5]); p.w = pk2(x[8 * s + 6], x[8 * s + 7]);
    return __builtin_bit_cast(bf16x8, p);
}
DI bf16x8 cat4(s16x4 lo, s16x4 hi) { return __builtin_shufflevector(lo, hi, 0, 1, 2, 3, 4, 5, 6, 7); }
DI float wave_sum(float v) {
#pragma unroll
    for (int o = 1; o < 64; o <<= 1) v += __shfl_xor(v, o);
    return v;
}
DI float half_sum32(float v) {
#pragma unroll
    for (int o = 1; o < 32; o <<= 1) v += __shfl_xor(v, o);
    return v;
}
DI void decode_row(int r, int& samp, int& b, int& p) {
    if (r < MPR) { samp = 0; b = r / LP; p = r - b * LP; } else { samp = 1; const int s = r - MPR; b = s >> 5; p = s & 31; }
}
DI int opaque_tid() { int t = threadIdx.x; asm volatile("" : "+v"(t)); return t; }
DI f32x16 zero16() { f32x16 z; for (int i = 0; i < 16; ++i) z[i] = 0.f; return z; }

DI void p0_rows(const Params& P, unsigned char* lds) {
    float* wffT = (float*)lds;
    const int t = opaque_tid();
#pragma unroll
    for (int i = 0; i < 16; ++i) { const int idx = t + 512 * i; const int c = idx >> 3, h = idx & 7; wffT[h * 1024 + c] = P.w_in[(size_t)c * INW + 6144 + h]; }
    __syncthreads();
    const int lane = t & 63, wave = t >> 6;
    bf16_t* XN = (bf16_t*)(P.ws + WS_XN); float* LOGF = (float*)(P.ws + WS_LOGF);
    for (int r = blockIdx.x * 8 + wave; r < MT; r += gridDim.x * 8) {
        int samp, b, p; decode_row(r, samp, b, p);
        const float* src = nullptr;
        if (samp) src = P.x_sample + (size_t)(r - MPR) * D;
        else if (p >= OFF) src = P.x_prompt + ((size_t)b * 8192 + (p - OFF)) * D;
        else if (p >= VAL0) src = P.meta + (size_t)(p - VAL0) * D;
        f32x4 v[4]; float ss = 0.f;
#pragma unroll
        for (int j = 0; j < 4; ++j) {
            if (src) v[j] = *(const f32x4*)(src + 4 * lane + 256 * j); else v[j] = (f32x4){0.f, 0.f, 0.f, 0.f};
            ss += v[j].x * v[j].x + v[j].y * v[j].y + v[j].z * v[j].z + v[j].w * v[j].w;
        }
        ss = wave_sum(ss);
        const float rstd = frsq(ss * (1.f / 1024.f) + EPS);
        float dot[8];
#pragma unroll
        for (int h = 0; h < 8; ++h) dot[h] = 0.f;
#pragma unroll
        for (int j = 0; j < 4; ++j) {
            const f32x4 g = *(const f32x4*)(P.norm1_g + 4 * lane + 256 * j);
            v[j] = v[j] * rstd * g;
            u32x2 o; o.x = pk2(v[j].x, v[j].y); o.y = pk2(v[j].z, v[j].w);
            *(u32x2*)(XN + (size_t)r * D + 4 * lane + 256 * j) = o;
#pragma unroll
            for (int h = 0; h < 8; ++h) { const f32x4 w = *(const f32x4*)(wffT + h * 1024 + 4 * lane + 256 * j); dot[h] += v[j].x * w.x + v[j].y * w.y + v[j].z * w.z + v[j].w * w.w; }
        }
#pragma unroll
        for (int h = 0; h < 8; ++h) dot[h] = wave_sum(dot[h]);
        float mine = dot[0];
#pragma unroll
        for (int h = 1; h < 8; ++h) mine = (lane == h) ? dot[h] : mine;
        if (lane < 8) {
            const float vv = mine + P.b_forget[lane];
            float lf = fminf(vv, 0.f) - log1pf(__expf(-fabsf(vv)));
            if (!samp && p < VAL0) lf = 0.f;
            LOGF[(size_t)r * 8 + lane] = lf;
            if (samp) P.out[O_SLF + (size_t)(r - MPR) * 8 + lane] = lf;
            else if (p >= VAL0) P.out[O_PLF + ((size_t)b * 8208 + (p - VAL0)) * 8 + lane] = lf;
        }
    }
    __syncthreads();
}

DI void transpose_item(const float* W, int ldw, int col0, int K, bf16_t* WT, int n0, int k0, float* tile) {
    const int t = opaque_tid(); const int nn = t & 63, kb = t >> 6;
#pragma unroll
    for (int i = 0; i < 8; ++i) { const int kk = kb + 8 * i; tile[kk * 65 + nn] = W[(size_t)(k0 + kk) * ldw + col0 + nn]; }
    __syncthreads();
    const int n = t >> 3, kc = t & 7;
    float f[8];
#pragma unroll
    for (int e = 0; e < 8; ++e) f[e] = tile[(8 * kc + e) * 65 + n];
    u32x4 o; o.x = pk2(f[0], f[1]); o.y = pk2(f[2], f[3]); o.z = pk2(f[4], f[5]); o.w = pk2(f[6], f[7]);
    *(u32x4*)(WT + (size_t)(n0 + n) * K + k0 + 8 * kc) = o;
    __syncthreads();
}

DI void p0_weights(const Params& P, unsigned char* lds) {
    float* tile = (float*)lds;
    constexpr int I0 = 16 * 128, I1 = 256, I4 = 16 * 64, I5 = 64 * 16;
    constexpr int NIT = I0 + 3 * I1 + I4 + I5;
    for (int it = blockIdx.x; it < NIT; it += gridDim.x) {
        int r = it;
        if (r < I0) { const int kt = r / 128, nt = r % 128; const int n0 = nt * 64; transpose_item(P.w_in, INW, n0 + (n0 >= 6144 ? 8 : 0), 1024, (bf16_t*)(P.ws + WS_WIN), n0, kt * 64, tile); continue; } r -= I0;
        if (r < I1) { transpose_item(P.w_ret_out, 1024, (r % 16) * 64, 1024, (bf16_t*)(P.ws + WS_WRET), (r % 16) * 64, (r / 16) * 64, tile); continue; } r -= I1;
        if (r < I1) { transpose_item(P.w_fox_out, 1024, (r % 16) * 64, 1024, (bf16_t*)(P.ws + WS_WFOX), (r % 16) * 64, (r / 16) * 64, tile); continue; } r -= I1;
        if (r < I1) { transpose_item(P.w_o, 1024, (r % 16) * 64, 1024, (bf16_t*)(P.ws + WS_WO), (r % 16) * 64, (r / 16) * 64, tile); continue; } r -= I1;
        if (r < I4) { transpose_item(P.w_ff1, 4096, (r % 64) * 64, 1024, (bf16_t*)(P.ws + WS_WFF1), (r % 64) * 64, (r / 64) * 64, tile); continue; } r -= I4;
        transpose_item(P.w_ff2, 1024, (r % 16) * 64, 4096, (bf16_t*)(P.ws + WS_WFF2), (r % 16) * 64, (r / 16) * 64, tile);
    }
}

DI void p0_misc(const Params& P) {
    f32x2* ROPE = (f32x2*)(P.ws + WS_ROPE);
    for (int idx = blockIdx.x * 512 + threadIdx.x; idx < LP * 64; idx += gridDim.x * 512) {
        const int pp = idx >> 6, c = idx & 63;
        const float pos = (float)(pp - 128);
        const float inv = exp2f(-(float)c * (13.287712379549449f / 64.f));
        const float ang = pos * inv;
        double td = (double)ang * 0.15915494309189535; td -= __builtin_rint(td);
        const float tf = (float)td;
        f32x2 cs; cs.x = __builtin_amdgcn_cosf(tf); cs.y = __builtin_amdgcn_sinf(tf);
        ROPE[idx] = cs;
    }
}

#define AS_GLOBAL __attribute__((address_space(1)))
#define AS_LDS __attribute__((address_space(3)))
DI void dma16(const void* g, unsigned char* l) { __builtin_amdgcn_global_load_lds((const AS_GLOBAL unsigned*)g, (AS_LDS unsigned*)l, 16, 0, 0); }
template <int NBW>
DI void gemm_mainloop(f32x16 (&acc)[2][NBW], const bf16_t* A, size_t lda, int m0, const bf16_t* Bt, size_t ldb, int n0, int K, unsigned char* lds, bool pre = false, bool only_issue = false) {
    constexpr int STAGE = 65536, BOFF = 32768;
    const int t = opaque_tid(), w = t >> 6, lane = t & 63, r = lane & 31, hh = lane >> 5, wm = w >> 1, wn = w & 1;
    const int drow = w * 8 + (lane >> 3);
    const int lchunk = (lane & 7) ^ ((drow >> 1) & 7);
    const bf16_t* ap = A + (size_t)(m0 + drow) * lda + lchunk * 8;
    const bf16_t* bp = Bt + (size_t)n0 * ldb + lchunk * 8;
    size_t bro[NBW];
#pragma unroll
    for (int j = 0; j < NBW; ++j) {
        const int rho = 64 * j + drow; const int wnh = rho / (32 * NBW), wi = rho % (32 * NBW);
        bro[j] = (size_t)(wnh * 32 * NBW + NBW * (wi & 31) + (wi >> 5)) * ldb;
    }
    unsigned char* ldst = lds + w * 1024 + lane * 16;
#define GEMM_ISSUE(KT, ST) do { const int k1_ = (KT) << 6; unsigned char* d_ = ldst + (ST) * STAGE; \
        _Pragma("unroll") for (int j_ = 0; j_ < 4; ++j_) dma16(ap + (size_t)(64 * j_) * lda + k1_, d_ + j_ * 8192); \
        _Pragma("unroll") for (int j_ = 0; j_ < NBW; ++j_) dma16(bp + bro[j_] + k1_, d_ + BOFF + j_ * 8192); } while (0)
    if (!pre) GEMM_ISSUE(0, 0);
    if (only_issue) return;
    __syncthreads();
    const int nk = K >> 6;
    const int xr = (r >> 1) & 7;
    int xo[4];
#pragma unroll
    for (int s = 0; s < 4; ++s) xo[s] = ((2 * s + hh) ^ xr) << 4;
    const int aofs = (wm * 64 + r) * 128;
    const int bofs = BOFF + (wn * 32 * NBW + r) * 128;
#pragma unroll 1
    for (int kt = 0; kt < nk; ++kt) {
        const unsigned char* st = lds + (kt & 1) * STAGE;
#pragma unroll
        for (int s = 0; s < 4; ++s) {
            if (s == 1 && kt + 1 < nk) GEMM_ISSUE(kt + 1, (kt + 1) & 1);
            bf16x8 a[2], b[NBW];
#pragma unroll
            for (int mb = 0; mb < 2; ++mb) a[mb] = *(const bf16x8*)(st + aofs + mb * 4096 + xo[s]);
#pragma unroll
            for (int nb = 0; nb < NBW; ++nb) b[nb] = *(const bf16x8*)(st + bofs + nb * 4096 + xo[s]);
#pragma unroll
            for (int mb = 0; mb < 2; ++mb)
#pragma unroll
                for (int nb = 0; nb < NBW; ++nb) acc[mb][nb] = MFMA(a[mb], b[nb], acc[mb][nb]);
        }
        __syncthreads();
    }
#undef GEMM_ISSUE
}

DI void epi_p1(const Params& P, f32x16 (&acc)[2][4], int m0, int n0) {
    const int t = opaque_tid(), w = t >> 6, lane = t & 63, r = lane & 31, hh = lane >> 5, wm = w >> 1, wn = w & 1;
    const int seg = (n0 + wn * 128) >> 7;
    unsigned char* ws = P.ws; float* out = P.out;
    const int rbase = m0 + wm * 64 + 4 * hh;
    const int c4 = 4 * r;
    if (seg < 8) {
        const bool isk = seg >= 4; const int head = seg & 3;
        bf16_t* dst = (bf16_t*)(ws + (isk ? WS_RK : WS_RQ)); const float scl = isk ? 0.08838834764831845f : 1.f;
        const float* rope = (const float*)(ws + WS_ROPE);
        const float sgn = (r < 16) ? -1.f : 1.f; const int f4 = 4 * (r & 15);
#pragma unroll
        for (int mb = 0; mb < 2; ++mb)
#pragma unroll
            for (int g = 0; g < 4; ++g) {
                const int rowb = rbase + mb * 32 + 8 * g; int samp, b, p0; decode_row(rowb, samp, b, p0);
                const int ridx0 = samp ? 4224 + p0 : p0;
#pragma unroll
                for (int e = 0; e < 4; ++e) {
                    const int i = 4 * g + e; const size_t row = rowb + e;
                    const f32x4 cs0 = *(const f32x4*)(rope + ((size_t)(ridx0 + e) * 64 + f4) * 2), cs1 = *(const f32x4*)(rope + ((size_t)(ridx0 + e) * 64 + f4) * 2 + 4);
                    const float cc[4] = {cs0.x, cs0.z, cs1.x, cs1.z}, sn[4] = {cs0.y, cs0.w, cs1.y, cs1.w};
                    float o[4];
#pragma unroll
                    for (int nb = 0; nb < 4; ++nb) { const float v = acc[mb][nb][i]; const float pv = __shfl_xor(v, 16); o[nb] = (v * cc[nb] + sgn * pv * sn[nb]) * scl; }
                    u32x2 ov; ov.x = pk2(o[0], o[1]); ov.y = pk2(o[2], o[3]);
                    __builtin_nontemporal_store(ov, (u32x2*)(dst + row * 512 + head * 128 + c4));
                }
            }
    } else if (seg < 24) {
        bf16_t* dst = (bf16_t*)(ws + (seg < 16 ? WS_RV : WS_RG)); const int cb = (seg & 7) * 128 + c4;
#pragma unroll
        for (int mb = 0; mb < 2; ++mb)
#pragma unroll
            for (int i = 0; i < 16; ++i) {
                const size_t row = rbase + mb * 32 + (i & 3) + 8 * (i >> 2);
                u32x2 ov; ov.x = pk2(acc[mb][0][i], acc[mb][1][i]); ov.y = pk2(acc[mb][2][i], acc[mb][3][i]);
                __builtin_nontemporal_store(ov, (u32x2*)(dst + row * 1024 + cb));
            }
    } else if (seg < 40) {
        const bool isk = seg >= 32; const int head = seg & 7;
        const f32x4 gv = *(const f32x4*)((isk ? P.k_norm_g : P.q_norm_g) + c4);
        bf16_t* dst = (bf16_t*)(ws + (isk ? WS_FK : WS_FQ));
#pragma unroll
        for (int mb = 0; mb < 2; ++mb)
#pragma unroll
            for (int g = 0; g < 4; ++g) {
                const int rowb = rbase + mb * 32 + 8 * g; int samp, b, p0; decode_row(rowb, samp, b, p0);
#pragma unroll
                for (int e = 0; e < 4; ++e) {
                    const int i = 4 * g + e; const size_t row = rowb + e; const int p = p0 + e;
                    float ss = 0.f;
#pragma unroll
                    for (int nb = 0; nb < 4; ++nb) ss += acc[mb][nb][i] * acc[mb][nb][i];
                    ss = half_sum32(ss);
                    const float rstd = frsq(ss * (1.f / 128.f) + EPS);
                    f32x4 y; y.x = acc[mb][0][i] * rstd * gv.x; y.y = acc[mb][1][i] * rstd * gv.y; y.z = acc[mb][2][i] * rstd * gv.z; y.w = acc[mb][3][i] * rstd * gv.w;
                    u32x2 ov; ov.x = pk2(y.x, y.y); ov.y = pk2(y.z, y.w);
                    __builtin_nontemporal_store(ov, (u32x2*)(dst + row * 1024 + head * 128 + c4));
                    if (isk) {
                        if (samp) __builtin_nontemporal_store(y, (f32x4*)(out + O_SK + ((size_t)(b * 32 + p) * 8 + head) * 128 + c4));
                        else if (p >= VAL0) __builtin_nontemporal_store(y, (f32x4*)(out + O_PK + (((size_t)b * 8208 + (p - VAL0)) * 8 + head) * 128 + c4));
                    }
                }
            }
    } else if (seg < 48) {
        const int head = seg & 7; bf16_t* VT = (bf16_t*)(ws + WS_VT);
#pragma unroll
        for (int mb = 0; mb < 2; ++mb)
#pragma unroll
            for (int g = 0; g < 4; ++g) {
                const int rowb = rbase + mb * 32 + 8 * g; int samp, b, p0; decode_row(rowb, samp, b, p0);
#pragma unroll
                for (int e = 0; e < 4; ++e) {
                    const int i = 4 * g + e; const int p = p0 + e;
                    f32x4 y; y.x = acc[mb][0][i]; y.y = acc[mb][1][i]; y.z = acc[mb][2][i]; y.w = acc[mb][3][i];
                    if (samp) __builtin_nontemporal_store(y, (f32x4*)(out + O_SV + ((size_t)(b * 32 + p) * 8 + head) * 128 + c4));
                    else if (p >= VAL0) __builtin_nontemporal_store(y, (f32x4*)(out + O_PV + (((size_t)b * 8208 + (p - VAL0)) * 8 + head) * 128 + c4));
                }
                if (!samp) {
#pragma unroll
                    for (int nb = 0; nb < 4; ++nb) {
                        u32x2 o; o.x = pk2(acc[mb][nb][4 * g], acc[mb][nb][4 * g + 1]); o.y = pk2(acc[mb][nb][4 * g + 2], acc[mb][nb][4 * g + 3]);
                        *(u32x2*)(VT + ((size_t)((b * 8 + head) * 128 + c4 + nb)) * LP + p0) = o;
                    }
                }
            }
    } else {
        const bool isb = seg >= 56; const int cb = (seg & 7) * 128 + c4;
        bf16_t* dp = (bf16_t*)out + (isb ? (size_t)33554432 : 0);
        bf16_t* dsm = (bf16_t*)(ws + (isb ? WS_GBS : WS_GAS));
#pragma unroll
        for (int mb = 0; mb < 2; ++mb)
#pragma unroll
            for (int g = 0; g < 4; ++g) {
                const int rowb = rbase + mb * 32 + 8 * g; int samp, b, p0; decode_row(rowb, samp, b, p0);
#pragma unroll
                for (int e = 0; e < 4; ++e) {
                    const int i = 4 * g + e; const int p = p0 + e;
                    bf16_t* d = nullptr;
                    if (samp) d = dsm + (size_t)(b * 32 + p) * 1024; else if (p >= OFF) d = dp + ((size_t)b * 8192 + (p - OFF)) * 1024;
                    if (d) {
                        float s[4];
#pragma unroll
                        for (int nb = 0; nb < 4; ++nb) s[nb] = frcp(1.f + ex2(-LOG2E * acc[mb][nb][i]));
                        u32x2 ov; ov.x = pk2(s[0], s[1]); ov.y = pk2(s[2], s[3]);
                        __builtin_nontemporal_store(ov, (u32x2*)(d + cb));
                    }
                }
            }
    }
}

DI void phase_p1(const Params& P, unsigned char* lds) {
    const bf16_t* A = (const bf16_t*)(P.ws + WS_XN); const bf16_t* Bt = (const bf16_t*)(P.ws + WS_WIN);
    constexpr int NTN = 32;
    bool pre = false;
#pragma unroll 1
    for (int tile = blockIdx.x; tile < NTM * NTN; tile += gridDim.x) {
        const int mt = tile / NTN, nt = tile % NTN;
        f32x16 acc[2][4];
#pragma unroll
        for (int a = 0; a < 2; ++a)
#pragma unroll
            for (int b = 0; b < 4; ++b) acc[a][b] = zero16();
        gemm_mainloop<4>(acc, A, 1024, mt * 256, Bt, 1024, nt * 256, 1024, lds, pre);
        { const int tn = tile + gridDim.x; pre = tn < NTM * NTN; if (pre) { const int mtn = tn / NTN, ntn_ = tn % NTN; f32x16 (&dummy)[2][4] = acc; gemm_mainloop<4>(dummy, A, 1024, mtn * 256, Bt, 1024, ntn_ * 256, 1024, lds, false, true); } }
        epi_p1(P, acc, mt * 256, nt * 256);
    }
}

DI void small_tile(const bf16_t* A, size_t lda, int a0, const bf16_t* Bt, size_t ldb, int b0, int K, float* ctile, float* red) {
    const int t = opaque_tid(), w = t >> 6, lane = t & 63, r = lane & 31, hh = lane >> 5;
    const int kper = K >> 3;
    const bf16_t* ap = A + (size_t)(a0 + r) * lda + w * kper + 8 * hh;
    const bf16_t* bp = Bt + (size_t)(b0 + r) * ldb + w * kper + 8 * hh;
    f32x16 acc = zero16();
#pragma unroll 4
    for (int k = 0; k < kper; k += 16) acc = MFMA(*(const bf16x8*)(ap + k), *(const bf16x8*)(bp + k), acc);
#pragma unroll
    for (int i = 0; i < 16; ++i) red[w * 1024 + i * 64 + lane] = acc[i];
    __syncthreads();
#pragma unroll
    for (int q = 0; q < 2; ++q) {
        const int e = t + 512 * q; float s = 0.f;
#pragma unroll
        for (int ww = 0; ww < 8; ++ww) s += red[ww * 1024 + e];
        const int i = e >> 6, ln = e & 63;
        ctile[crow(i, ln >> 5) * 33 + (ln & 31)] = s;
    }
    __syncthreads();
}

DI void phase_p4(const Params& P, unsigned char* lds) {
    const bf16_t* RO = (const bf16_t*)(P.ws + WS_RG); const bf16_t* FO = (const bf16_t*)(P.ws + WS_FQ);
    const bf16_t* W1 = (const bf16_t*)(P.ws + WS_WRET); const bf16_t* W2 = (const bf16_t*)(P.ws + WS_WFOX);
    bf16_t* M = (bf16_t*)(P.ws + WS_M);
    const bf16_t* GAp = (const bf16_t*)P.out; const bf16_t* GBp = GAp + (size_t)33554432;
    const bf16_t* GAs = (const bf16_t*)(P.ws + WS_GAS); const bf16_t* GBs = (const bf16_t*)(P.ws + WS_GBS);
    const int t = opaque_tid(), w = t >> 6, lane = t & 63, r = lane & 31, hh = lane >> 5, wm = w >> 1, wn = w & 1;
    constexpr int NTN = 8;
    bool pre = false;
#pragma unroll 1
    for (int tile = blockIdx.x; tile < 128 * NTN; tile += gridDim.x) {
        const int mt = tile / NTN, nt = tile % NTN; const int m0 = (mt >> 5) * LP + OFF + (mt & 31) * 256, n0 = nt * 128;
        f32x16 a1[2][2], a2[2][2];
#pragma unroll
        for (int a = 0; a < 2; ++a)
#pragma unroll
            for (int b = 0; b < 2; ++b) { a1[a][b] = zero16(); a2[a][b] = zero16(); }
        gemm_mainloop<2>(a1, RO, 1024, m0, W1, 1024, n0, 1024, lds, pre);
        gemm_mainloop<2>(a2, FO, 1024, m0, W2, 1024, n0, 1024, lds);
        { const int tn = tile + gridDim.x; pre = tn < 128 * NTN; if (pre) { const int mtn = tn / NTN, ntn_ = tn % NTN; gemm_mainloop<2>(a1, RO, 1024, (mtn >> 5) * LP + OFF + (mtn & 31) * 256, W1, 1024, ntn_ * 128, 1024, lds, false, true); } }
        const int col = n0 + wn * 64 + 2 * r;
        const size_t crow0 = (size_t)mt * 256 + wm * 64 + 4 * hh;
#pragma unroll
        for (int mb = 0; mb < 2; ++mb) {
            unsigned ua[16], ub[16];
#pragma unroll
            for (int i = 0; i < 16; ++i) {
                const size_t ci = (crow0 + mb * 32 + (i & 3) + 8 * (i >> 2)) * 1024 + col;
                ua[i] = *(const unsigned*)(GAp + ci); ub[i] = *(const unsigned*)(GBp + ci);
            }
#pragma unroll
            for (int i = 0; i < 16; ++i) {
                const size_t row = (size_t)m0 + wm * 64 + mb * 32 + crow(i, hh);
                const float m0v = bflo(ua[i]) * a1[mb][0][i] + bflo(ub[i]) * a2[mb][0][i];
                const float m1v = bfhi(ua[i]) * a1[mb][1][i] + bfhi(ub[i]) * a2[mb][1][i];
                __builtin_nontemporal_store(pk2(m0v, m1v), (unsigned*)(M + row * 1024 + col));
            }
        }
    }
    {
        float* red = (float*)lds; float* c1 = (float*)(lds + 32768); float* c2 = (float*)(lds + 32768 + 4352);
#pragma unroll 1
        for (int pc = blockIdx.x; pc < 8 * 32; pc += gridDim.x) {
            const int rg = pc >> 5, cg = pc & 31;
            small_tile(RO, 1024, MPR + 32 * rg, W1, 1024, 32 * cg, 1024, c1, red);
            small_tile(FO, 1024, MPR + 32 * rg, W2, 1024, 32 * cg, 1024, c2, red);
            const int rl = t >> 4, cl = (t & 15) * 2; const int srow = 32 * rg + rl, col = 32 * cg + cl;
            const unsigned ua = *(const unsigned*)(GAs + (size_t)srow * 1024 + col), ub = *(const unsigned*)(GBs + (size_t)srow * 1024 + col);
            const float m0v = bflo(ua) * c1[rl * 33 + cl] + bflo(ub) * c2[rl * 33 + cl];
            const float m1v = bfhi(ua) * c1[rl * 33 + cl + 1] + bfhi(ub) * c2[rl * 33 + cl + 1];
            __builtin_nontemporal_store(pk2(m0v, m1v), (unsigned*)(M + (size_t)(MPR + srow) * 1024 + col));
            __syncthreads();
        }
    }
}

DI void phase_p5(const Params& P, unsigned char* lds) {
    const bf16_t* M = (const bf16_t*)(P.ws + WS_M); const bf16_t* W = (const bf16_t*)(P.ws + WS_WO);
    bf16_t* A2 = (bf16_t*)(P.ws + WS_A2); float* SSQ = (float*)(P.ws + WS_SSQ);
    const int t = opaque_tid(), w = t >> 6, lane = t & 63, r = lane & 31, hh = lane >> 5, wm = w >> 1, wn = w & 1;
    constexpr int NTN = 4;
    bool pre = false;
#pragma unroll 1
    for (int tile = blockIdx.x; tile < 128 * NTN; tile += gridDim.x) {
        const int mt = tile / NTN, nt = tile % NTN; const int m0 = (mt >> 5) * LP + OFF + (mt & 31) * 256, n0 = nt * 256;
        f32x16 acc[2][4];
#pragma unroll
        for (int a = 0; a < 2; ++a)
#pragma unroll
            for (int b = 0; b < 4; ++b) acc[a][b] = zero16();
        gemm_mainloop<4>(acc, M, 1024, m0, W, 1024, n0, 1024, lds, pre);
        { const int tn = tile + gridDim.x; pre = tn < 128 * NTN; if (pre) { const int mtn = tn / NTN, ntn_ = tn % NTN; f32x16 (&dummy)[2][4] = acc; gemm_mainloop<4>(dummy, M, 1024, (mtn >> 5) * LP + OFF + (mtn & 31) * 256, W, 1024, ntn_ * 256, 1024, lds, false, true); } }
        const int col = n0 + wn * 128 + 4 * r;
        const f32x4 g2 = *(const f32x4*)(P.norm2_g + col);
        const size_t crow0 = (size_t)mt * 256 + wm * 64 + 4 * hh;
#pragma unroll
        for (int mb = 0; mb < 2; ++mb) {
#pragma unroll
          for (int hf = 0; hf < 2; ++hf) {
            f32x4 xv[16];
#pragma unroll
            for (int i = 8 * hf; i < 8 * hf + 8; ++i) xv[i] = *(const f32x4*)(P.x_prompt + (crow0 + mb * 32 + (i & 3) + 8 * (i >> 2)) * 1024 + col);
#pragma unroll
            for (int i = 8 * hf; i < 8 * hf + 8; ++i) {
                const size_t lr = mb * 32 + (i & 3) + 8 * (i >> 2); const size_t row = (size_t)m0 + wm * 64 + 4 * hh + lr;
                f32x4 h2; h2.x = xv[i].x + acc[mb][0][i]; h2.y = xv[i].y + acc[mb][1][i]; h2.z = xv[i].z + acc[mb][2][i]; h2.w = xv[i].w + acc[mb][3][i];
                __builtin_nontemporal_store(h2, (f32x4*)(P.out + O_Y + (crow0 + lr) * 1024 + col));
                u32x2 ov; ov.x = pk2(h2.x * g2.x, h2.y * g2.y); ov.y = pk2(h2.z * g2.z, h2.w * g2.w);
                __builtin_nontemporal_store(ov, (u32x2*)(A2 + row * 1024 + col));
                float ss = (h2.x * h2.x + h2.y * h2.y) + (h2.z * h2.z + h2.w * h2.w);
                ss = half_sum32(ss);
                if (r == 0) SSQ[row * 8 + nt * 2 + wn] = ss;
            }
          }
        }
    }
    {
        float* red = (float*)lds; float* c1 = (float*)(lds + 32768); float* SSQS = (float*)(P.ws + WS_SSQS);
#pragma unroll 1
        for (int pc = blockIdx.x; pc < 8 * 32; pc += gridDim.x) {
            const int rg = pc >> 5, cg = pc & 31;
            small_tile(M, 1024, MPR + 32 * rg, W, 1024, 32 * cg, 1024, c1, red);
            const int rl = t >> 4, cl = (t & 15) * 2; const int srow = 32 * rg + rl, col = 32 * cg + cl;
            const f32x2 xv = *(const f32x2*)(P.x_sample + (size_t)srow * 1024 + col);
            f32x2 h2; h2.x = xv.x + c1[rl * 33 + cl]; h2.y = xv.y + c1[rl * 33 + cl + 1];
            __builtin_nontemporal_store(h2, (f32x2*)(P.out + O_YS + (size_t)srow * 1024 + col));
            const f32x2 g2 = *(const f32x2*)(P.norm2_g + col);
            __builtin_nontemporal_store(pk2(h2.x * g2.x, h2.y * g2.y), (unsigned*)(A2 + (size_t)(MPR + srow) * 1024 + col));
            float ss = h2.x * h2.x + h2.y * h2.y;
#pragma unroll
            for (int o = 1; o < 16; o <<= 1) ss += __shfl_xor(ss, o);
            if ((t & 15) == 0) SSQS[srow * 32 + cg] = ss;
            __syncthreads();
        }
    }
}

DI void phase_p6(const Params& P, unsigned char* lds) {
    const bf16_t* A2 = (const bf16_t*)(P.ws + WS_A2); const bf16_t* W = (const bf16_t*)(P.ws + WS_WFF1);
    bf16_t* U = (bf16_t*)(P.ws + WS_U); const float* SSQ = (const float*)(P.ws + WS_SSQ);
    const int t = opaque_tid(), w = t >> 6, lane = t & 63, r = lane & 31, hh = lane >> 5, wm = w >> 1, wn = w & 1;
    constexpr int NTN = 16;
    bool pre = false; int rtpar = 0;
#pragma unroll 1
    for (int tile = blockIdx.x; tile < 128 * NTN; tile += gridDim.x) {
        const int mt = tile / NTN, nt = tile % NTN; const int m0 = (mt >> 5) * LP + OFF + (mt & 31) * 256, n0 = nt * 256;
        f32x16 acc[2][4];
#pragma unroll
        for (int a = 0; a < 2; ++a)
#pragma unroll
            for (int b = 0; b < 4; ++b) acc[a][b] = zero16();
        {
            float* rt = (float*)(lds + 131072 + (rtpar & 1) * 1024);
            if (t < 256) {
                const size_t row = (size_t)m0 + t;
                const f32x4 s0 = *(const f32x4*)(SSQ + row * 8), s1 = *(const f32x4*)(SSQ + row * 8 + 4);
                const float ss = ((s0.x + s0.y) + (s0.z + s0.w)) + ((s1.x + s1.y) + (s1.z + s1.w));
                rt[t] = frsq(ss * (1.f / 1024.f) + EPS);
            }
        }
        gemm_mainloop<4>(acc, A2, 1024, m0, W, 1024, n0, 1024, lds, pre);
        { const int tn = tile + gridDim.x; pre = tn < 128 * NTN; if (pre) { const int mtn = tn / NTN, ntn_ = tn % NTN; f32x16 (&dummy)[2][4] = acc; gemm_mainloop<4>(dummy, A2, 1024, (mtn >> 5) * LP + OFF + (mtn & 31) * 256, W, 1024, ntn_ * 256, 1024, lds, false, true); } }
        const int col = n0 + wn * 128 + 4 * r;
#pragma unroll
        for (int mb = 0; mb < 2; ++mb)
#pragma unroll
            for (int i = 0; i < 16; ++i) {
                const size_t row = m0 + wm * 64 + mb * 32 + crow(i, hh);
                const float rstd = ((const float*)(lds + 131072 + (rtpar & 1) * 1024))[wm * 64 + mb * 32 + crow(i, hh)];
                float u[4];
#pragma unroll
                for (int nb = 0; nb < 4; ++nb) { const float v = fmaxf(acc[mb][nb][i] * rstd, 0.f); u[nb] = v * v; }
                u32x2 ov; ov.x = pk2(u[0], u[1]); ov.y = pk2(u[2], u[3]);
                __builtin_nontemporal_store(ov, (u32x2*)(U + row * 4096 + col));
            }
        ++rtpar;
    }
    {
        float* red = (float*)lds; float* c1 = (float*)(lds + 32768); const float* SSQS = (const float*)(P.ws + WS_SSQS);
#pragma unroll 1
        for (int pc = blockIdx.x; pc < 8 * 128; pc += gridDim.x) {
            const int rg = pc >> 7, cg = pc & 127;
            small_tile(A2, 1024, MPR + 32 * rg, W, 1024, 32 * cg, 1024, c1, red);
            const int rl = t >> 4, cl = (t & 15) * 2; const int srow = 32 * rg + rl, col = 32 * cg + cl;
            float ss = 0.f;
#pragma unroll
            for (int j = 0; j < 8; ++j) { const f32x4 sv = *(const f32x4*)(SSQS + srow * 32 + 4 * j); ss += (sv.x + sv.y) + (sv.z + sv.w); }
            const float rstd = frsq(ss * (1.f / 1024.f) + EPS);
            const float u0 = fmaxf(c1[rl * 33 + cl] * rstd, 0.f), u1 = fmaxf(c1[rl * 33 + cl + 1] * rstd, 0.f);
            __builtin_nontemporal_store(pk2(u0 * u0, u1 * u1), (unsigned*)(U + (size_t)(MPR + srow) * 4096 + col));
            __syncthreads();
        }
    }
}

DI void phase_p7(const Params& P, unsigned char* lds) {
    const bf16_t* U = (const bf16_t*)(P.ws + WS_U); const bf16_t* W = (const bf16_t*)(P.ws + WS_WFF2);
    const int t = opaque_tid(), w = t >> 6, lane = t & 63, r = lane & 31, hh = lane >> 5, wm = w >> 1, wn = w & 1;
    constexpr int NTN = 4;
    bool pre = false;
#pragma unroll 1
    for (int tile = blockIdx.x; tile < 128 * NTN; tile += gridDim.x) {
        const int mt = tile / NTN, nt = tile % NTN; const int m0 = (mt >> 5) * LP + OFF + (mt & 31) * 256, n0 = nt * 256;
        f32x16 acc[2][4];
#pragma unroll
        for (int a = 0; a < 2; ++a)
#pragma unroll
            for (int b = 0; b < 4; ++b) acc[a][b] = zero16();
        gemm_mainloop<4>(acc, U, 4096, m0, W, 4096, n0, 4096, lds, pre);
        { const int tn = tile + gridDim.x; pre = tn < 128 * NTN; if (pre) { const int mtn = tn / NTN, ntn_ = tn % NTN; f32x16 (&dummy)[2][4] = acc; gemm_mainloop<4>(dummy, U, 4096, (mtn >> 5) * LP + OFF + (mtn & 31) * 256, W, 4096, ntn_ * 256, 4096, lds, false, true); } }
        const int col = n0 + wn * 128 + 4 * r;
        const size_t crow0 = (size_t)mt * 256 + wm * 64 + 4 * hh;
#pragma unroll
        for (int mb = 0; mb < 2; ++mb) {
#pragma unroll
          for (int hf = 0; hf < 2; ++hf) {
            f32x4 yv[16];
#pragma unroll
            for (int i = 8 * hf; i < 8 * hf + 8; ++i) yv[i] = *(const f32x4*)(P.out + O_Y + (crow0 + mb * 32 + (i & 3) + 8 * (i >> 2)) * 1024 + col);
#pragma unroll
            for (int i = 8 * hf; i < 8 * hf + 8; ++i) {
                f32x4 o = yv[i]; o.x += acc[mb][0][i]; o.y += acc[mb][1][i]; o.z += acc[mb][2][i]; o.w += acc[mb][3][i];
                __builtin_nontemporal_store(o, (f32x4*)(P.out + O_Y + (crow0 + mb * 32 + (i & 3) + 8 * (i >> 2)) * 1024 + col));
            }
          }
        }
    }
    {
        float* red = (float*)lds; float* c1 = (float*)(lds + 32768);
#pragma unroll 1
        for (int pc = blockIdx.x; pc < 8 * 32; pc += gridDim.x) {
            const int rg = pc >> 5, cg = pc & 31;
            small_tile(U, 4096, MPR + 32 * rg, W, 4096, 32 * cg, 4096, c1, red);
            const int rl = t >> 4, cl = (t & 15) * 2; const int srow = 32 * rg + rl, col = 32 * cg + cl;
            f32x2* yp = (f32x2*)(P.out + O_YS + (size_t)srow * 1024 + col);
            f32x2 yv = *yp; yv.x += c1[rl * 33 + cl]; yv.y += c1[rl * 33 + cl + 1]; *yp = yv;
            __syncthreads();
        }
    }
}

template <bool OUT>
DI void ret_chunk(const Params& P, unsigned char* lds, f32x16 (&S)[4], size_t row0, int CL, int head, float lg2_in) {
    float lg2 = lg2_in; asm volatile("" : "+v"(lg2));
    const int t = opaque_tid(), w = t >> 6, lane = t & 63, r = lane & 31, hh = lane >> 5;
    const bf16_t* RQ = (const bf16_t*)(P.ws + WS_RQ); const bf16_t* RK = (const bf16_t*)(P.ws + WS_RK); const bf16_t* RV = (const bf16_t*)(P.ws + WS_RV);
    bf16_t* RG = (bf16_t*)(P.ws + WS_RG);
    unsigned char* Qs = lds; unsigned char* Ks = lds + 17408; unsigned char* KTs = lds + 34816; unsigned char* VTs = lds + 53248; float* OUTs = (float*)(lds + 90112);
    {
        const int n = t & 63; const bool live = n < CL;
        const float kdec = ex2((float)(CL - 1 - n) * lg2);
#pragma unroll
        for (int i = 0; i < 2; ++i) {
            const int dc = (t >> 6) + 8 * i;
            u32x4 kv = (u32x4){0u, 0u, 0u, 0u};
            if (live) kv = *(const u32x4*)(RK + (row0 + n) * 512 + head * 128 + dc * 8);
            if (OUT) {
                u32x4 qv = (u32x4){0u, 0u, 0u, 0u};
                if (live) qv = *(const u32x4*)(RQ + (row0 + n) * 512 + head * 128 + dc * 8);
                *(u32x4*)(Qs + n * 272 + dc * 16) = qv; *(u32x4*)(Ks + n * 272 + dc * 16) = kv;
            }
#pragma unroll
            for (int e = 0; e < 4; ++e) {
                const unsigned u = kv[e];
                *(bf16_t*)(KTs + (dc * 8 + 2 * e) * 144 + n * 2) = f2bf(bflo(u) * kdec);
                *(bf16_t*)(KTs + (dc * 8 + 2 * e + 1) * 144 + n * 2) = f2bf(bfhi(u) * kdec);
            }
        }
#pragma unroll
        for (int i = 0; i < 4; ++i) {
            const int vc = (t >> 6) + 8 * i;
            u32x4 vv = (u32x4){0u, 0u, 0u, 0u};
            if (live) vv = *(const u32x4*)(RV + (row0 + n) * 1024 + head * 256 + vc * 8);
#pragma unroll
            for (int e = 0; e < 4; ++e) {
                const unsigned u = vv[e];
                *(bf16_t*)(VTs + (vc * 8 + 2 * e) * 144 + n * 2) = (bf16_t)(u & 0xffffu);
                *(bf16_t*)(VTs + (vc * 8 + 2 * e + 1) * 144 + n * 2) = (bf16_t)(u >> 16);
            }
        }
    }
    __syncthreads();
    __builtin_amdgcn_sched_barrier(0);
    if (OUT) {
        f32x16 o[2]; o[0] = zero16(); o[1] = zero16();
#pragma unroll
        for (int db = 0; db < 4; ++db)
#pragma unroll
            for (int sp = 0; sp < 2; ++sp) {
                const bf16x8 bs = pack8(S[db], sp);
#pragma unroll
                for (int nbo = 0; nbo < 2; ++nbo) {
                    const unsigned char* qa = Qs + (32 * nbo + r) * 272 + (32 * db + 16 * sp + 4 * hh) * 2;
                    const bf16x8 a = cat4(*(const s16x4*)qa, *(const s16x4*)(qa + 16));
                    o[nbo] = MFMA(a, bs, o[nbo]);
                }
            }
        __builtin_amdgcn_sched_barrier(0);
#pragma unroll
        for (int nbo = 0; nbo < 2; ++nbo)
#pragma unroll
            for (int i = 0; i < 16; ++i) o[nbo][i] *= ex2((float)(32 * nbo + crow(i, hh) + 1) * lg2);
        __builtin_amdgcn_sched_barrier(0);
#pragma unroll
        for (int tix = 0; tix < 3; ++tix) {
            const int mb = (tix == 2) ? 1 : 0, nb = (tix == 0) ? 0 : 1;
            __builtin_amdgcn_sched_barrier(0);
            f32x16 x = zero16();
#pragma unroll
            for (int s = 0; s < 8; ++s) {
                const bf16x8 a = *(const bf16x8*)(Ks + (32 * mb + r) * 272 + (16 * s + 8 * hh) * 2);
                const bf16x8 b = *(const bf16x8*)(Qs + (32 * nb + r) * 272 + (16 * s + 8 * hh) * 2);
                x = MFMA(a, b, x);
            }
#pragma unroll
            for (int i = 0; i < 16; ++i) {
                const int d = (32 * nb + r) - (32 * mb + crow(i, hh));
                x[i] = (d >= 0) ? x[i] * ex2((float)d * lg2) : 0.f;
            }
#pragma unroll
            for (int sp = 0; sp < 2; ++sp) {
                const bf16x8 xa = pack8(x, sp);
                const unsigned char* va = VTs + (32 * w + r) * 144 + (32 * mb + 16 * sp + 4 * hh) * 2;
                const bf16x8 b = cat4(*(const s16x4*)va, *(const s16x4*)(va + 16));
                o[nb] = MFMA(xa, b, o[nb]);
            }
        }
        __builtin_amdgcn_sched_barrier(0);
#pragma unroll
        for (int nb = 0; nb < 2; ++nb)
#pragma unroll
            for (int i = 0; i < 16; ++i) OUTs[(32 * nb + crow(i, hh)) * 260 + 32 * w + r] = o[nb][i];
        __builtin_amdgcn_sched_barrier(0);
    }
    {
        const float gC = ex2((float)CL * lg2);
#pragma unroll
        for (int db = 0; db < 4; ++db) S[db] = S[db] * gC;
#pragma unroll
        for (int s = 0; s < 4; ++s) {
            const bf16x8 b = *(const bf16x8*)(VTs + (32 * w + r) * 144 + (16 * s + 8 * hh) * 2);
#pragma unroll
            for (int db = 0; db < 4; ++db) {
                const bf16x8 a = *(const bf16x8*)(KTs + (32 * db + r) * 144 + (16 * s + 8 * hh) * 2);
                S[db] = MFMA(a, b, S[db]);
            }
        }
    }
    __syncthreads();
    __builtin_amdgcn_sched_barrier(0);
    if (OUT) {
        const int n = t >> 3, sg = t & 7;
        f32x4 xv[8]; float s1 = 0.f, s2 = 0.f;
#pragma unroll
        for (int j = 0; j < 8; ++j) {
            xv[j] = *(const f32x4*)(OUTs + n * 260 + sg * 32 + 4 * j);
            s1 += (xv[j].x + xv[j].y) + (xv[j].z + xv[j].w);
            s2 += (xv[j].x * xv[j].x + xv[j].y * xv[j].y) + (xv[j].z * xv[j].z + xv[j].w * xv[j].w);
        }
#pragma unroll
        for (int o = 1; o < 8; o <<= 1) { s1 += __shfl_xor(s1, o); s2 += __shfl_xor(s2, o); }
        const float mean = s1 * (1.f / 256.f); const float var = fmaxf(s2 * (1.f / 256.f) - mean * mean, 0.f);
        const float rstd = frsq(var + EPS);
        if (n < CL) {
            bf16_t* gp = RG + (row0 + n) * 1024 + head * 256 + sg * 32;
            const float* gn = P.ret_gn_g + head * 256 + sg * 32;
            u32x4 gu[4];
#pragma unroll
            for (int j = 0; j < 4; ++j) gu[j] = *(const u32x4*)(gp + 8 * j);
#pragma unroll
            for (int j = 0; j < 4; ++j) {
                const f32x4 g0 = *(const f32x4*)(gn + 8 * j), g1 = *(const f32x4*)(gn + 8 * j + 4);
                const f32x4 xa = xv[2 * j], xb = xv[2 * j + 1];
                float y[8], gt[8];
                gt[0] = bflo(gu[j].x); gt[1] = bfhi(gu[j].x); gt[2] = bflo(gu[j].y); gt[3] = bfhi(gu[j].y); gt[4] = bflo(gu[j].z); gt[5] = bfhi(gu[j].z); gt[6] = bflo(gu[j].w); gt[7] = bfhi(gu[j].w);
                y[0] = (xa.x - mean) * rstd * g0.x; y[1] = (xa.y - mean) * rstd * g0.y; y[2] = (xa.z - mean) * rstd * g0.z; y[3] = (xa.w - mean) * rstd * g0.w;
                y[4] = (xb.x - mean) * rstd * g1.x; y[5] = (xb.y - mean) * rstd * g1.y; y[6] = (xb.z - mean) * rstd * g1.z; y[7] = (xb.w - mean) * rstd * g1.w;
#pragma unroll
                for (int e = 0; e < 8; ++e) y[e] *= gt[e] * frcp(1.f + ex2(-LOG2E * gt[e]));
                u32x4 ou; ou.x = pk2(y[0], y[1]); ou.y = pk2(y[2], y[3]); ou.z = pk2(y[4], y[5]); ou.w = pk2(y[6], y[7]);
                *(u32x4*)(gp + 8 * j) = ou;
            }
        }
    }
}

DI float head_lg2(int head) { return log2f(1.f - 1.f / (float)(32 << head)); }

DI void ret_passA_item(const Params& P, unsigned char* lds, int item) {
    const int bh = item / 12, g = item % 12, b = bh >> 2, head = bh & 3;
    const int t = opaque_tid(), w = t >> 6, lane = t & 63;
    const float lg2 = head_lg2(head);
    f32x16 S[4];
#pragma unroll
    for (int db = 0; db < 4; ++db) S[db] = zero16();
#pragma unroll 1
    for (int c = 0; c < 10; ++c) ret_chunk<false>(P, lds, S, (size_t)b * LP + 640 * g + 64 * c, 64, head, lg2);
    float* T = (float*)(P.ws + WS_TG) + ((size_t)item * 8 + w) * 4096;
#pragma unroll
    for (int db = 0; db < 4; ++db)
#pragma unroll
        for (int i = 0; i < 16; ++i) T[(db * 16 + i) * 64 + lane] = S[db][i];
}

DI void ret_passC_prompt(const Params& P, unsigned char* lds, int bh, int g) {
    const int b = bh >> 2, head = bh & 3;
    const int t = opaque_tid(), w = t >> 6, lane = t & 63, r = lane & 31, hh = lane >> 5;
    const float lg2 = head_lg2(head);
    f32x16 S[4];
#pragma unroll
    for (int db = 0; db < 4; ++db) S[db] = zero16();
    const float g640 = ex2(640.f * lg2);
#pragma unroll 1
    for (int gp = 0; gp < g; ++gp) {
        const float* T = (const float*)(P.ws + WS_TG) + ((size_t)(bh * 12 + gp) * 8 + w) * 4096;
#pragma unroll
        for (int db = 0; db < 4; ++db)
#pragma unroll
            for (int i = 0; i < 16; ++i) S[db][i] = S[db][i] * g640 + T[(db * 16 + i) * 64 + lane];
    }
#pragma unroll 1
    for (int c = 0; c < 10; ++c) ret_chunk<true>(P, lds, S, (size_t)b * LP + 640 * g + 64 * c, 64, head, lg2);
    if (g == 12) {
        float* dst = P.out + O_PST + (size_t)bh * 32768;
#pragma unroll
        for (int db = 0; db < 4; ++db)
#pragma unroll
            for (int i = 0; i < 16; ++i) dst[(32 * db + crow(i, hh)) * 256 + 32 * w + r] = S[db][i];
    }
    __syncthreads();
}

DI void ret_sample_item(const Params& P, unsigned char* lds, int sb, int head) {
    const int t = opaque_tid(), w = t >> 6, lane = t & 63, r = lane & 31, hh = lane >> 5;
    const float lg2 = head_lg2(head);
    const float* src = P.state_ret + (size_t)(sb * 4 + head) * 32768;
    f32x16 S[4];
#pragma unroll
    for (int db = 0; db < 4; ++db)
#pragma unroll
        for (int i = 0; i < 16; ++i) S[db][i] = src[(32 * db + crow(i, hh)) * 256 + 32 * w + r];
    ret_chunk<true>(P, lds, S, (size_t)MPR + sb * 32, 32, head, lg2);
    float* dst = P.out + O_SST + (size_t)(sb * 4 + head) * 32768;
#pragma unroll
    for (int db = 0; db < 4; ++db)
#pragma unroll
        for (int i = 0; i < 16; ++i) dst[(32 * db + crow(i, hh)) * 256 + 32 * w + r] = S[db][i];
    __syncthreads();
}

DI double wave_incl_scan(double v, int lane) {
#pragma unroll
    for (int o = 1; o < 64; o <<= 1) { const double u = __shfl_up(v, o); if (lane >= o) v += u; }
    return v;
}
DI void cumsum_seq(const Params& P, int seq, int lane) {
    if (seq < 32) {
        const int b = seq >> 3, h = seq & 7;
        const float* lf = (const float*)(P.ws + WS_LOGF) + (size_t)b * LP * 8 + h;
        float* nck = (float*)(P.ws + WS_NCKP) + (size_t)seq * LP;
        double loc = 0.0;
#pragma unroll 1
        for (int bt = 0; bt < 5; ++bt) {
            float v[26];
#pragma unroll
            for (int j = 0; j < 26; ++j) v[j] = lf[(size_t)(130 * lane + 26 * bt + j) * 8];
#pragma unroll
            for (int j = 0; j < 26; ++j) loc += (double)v[j];
        }
        const double inc = wave_incl_scan(loc, lane);
        double run = inc - loc;
#pragma unroll 1
        for (int bt = 0; bt < 5; ++bt) {
            float v[26];
#pragma unroll
            for (int j = 0; j < 26; ++j) v[j] = lf[(size_t)(130 * lane + 26 * bt + j) * 8];
#pragma unroll
            for (int j = 0; j < 26; ++j) { const int p = 130 * lane + 26 * bt + j; run += (double)v[j]; nck[p] = (p < VAL0) ? -1e30f : -(float)run; }
        }
    } else {
        const int s = seq - 32, sb = s >> 3, h = s & 7;
        const float* cl = P.cache_logf + (size_t)sb * 4096 * 8 + h;
        float* nck = (float*)(P.ws + WS_NCKS) + (size_t)s * 4128;
        double loc = 0.0;
#pragma unroll 1
        for (int bt = 0; bt < 4; ++bt) {
            float v[16];
#pragma unroll
            for (int j = 0; j < 16; ++j) v[j] = cl[(size_t)(64 * lane + 16 * bt + j) * 8];
#pragma unroll
            for (int j = 0; j < 16; ++j) loc += (double)v[j];
        }
        const double inc = wave_incl_scan(loc, lane);
        double run = inc - loc;
#pragma unroll 1
        for (int bt = 0; bt < 4; ++bt) {
            float v[16];
#pragma unroll
            for (int j = 0; j < 16; ++j) v[j] = cl[(size_t)(64 * lane + 16 * bt + j) * 8];
#pragma unroll
            for (int j = 0; j < 16; ++j) { const int p = 64 * lane + 16 * bt + j; run += (double)v[j]; nck[p] = -(float)run; }
        }
        const double tot = __shfl(inc, 63);
        const float* lf = (const float*)(P.ws + WS_LOGF) + ((size_t)MPR + sb * 32) * 8 + h;
        const double mine = (lane < 32) ? (double)lf[(size_t)lane * 8] : 0.0;
        const double inc2 = wave_incl_scan(mine, lane);
        if (lane < 32) nck[4096 + lane] = -(float)(tot + inc2);
    }
}

DI void phase_p2(const Params& P, unsigned char* lds) {
    constexpr int NRET = 192, NCUM = 12;
    for (int it = blockIdx.x; it < NRET + NCUM; it += gridDim.x) {
        if (it < NRET) { ret_passA_item(P, lds, it); __syncthreads(); }
        else { const int seq = (it - NRET) * 8 + (threadIdx.x >> 6); cumsum_seq(P, seq, threadIdx.x & 63); }
    }
}

DI void attn_prompt_item(const Params& P, unsigned char* lds, int b, int head, int qb, float qkb2) {
    const int t = opaque_tid(), w = t >> 6, lane = t & 63, r = lane & 31, hh = lane >> 5;
    const bf16_t* FK = (const bf16_t*)(P.ws + WS_FK); const bf16_t* VT = (const bf16_t*)(P.ws + WS_VT); bf16_t* FQ = (bf16_t*)(P.ws + WS_FQ);
    const float* NCK = (const float*)(P.ws + WS_NCKP) + (size_t)(b * 8 + head) * LP;
    const int q0 = OFF + 256 * qb, qw0 = q0 + 32 * w, myq = qw0 + r;
    const float cref = -NCK[q0];
    bf16_t* qp = FQ + ((size_t)b * LP + myq) * 1024 + head * 128;
    bf16x8 qf[8];
#pragma unroll
    for (int s = 0; s < 8; ++s) qf[s] = *(const bf16x8*)(qp + 16 * s + 8 * hh);
    f32x16 o[4];
#pragma unroll
    for (int db = 0; db < 4; ++db) o[db] = zero16();
    float m_run = -1e30f, l_run = 0.f;
    const int kt_last = (q0 + 255) >> 6;
    constexpr int BUF = 36864, VOFF = 17408, BOFF = 35840, WMOFF = 3 * BUF;
    const int kkey = t >> 4, kdc = t & 15;
    const int vd = t >> 3, vkc = t & 7;
    const bf16_t* kg = FK + ((size_t)b * LP + kkey) * 1024 + head * 128 + kdc * 8;
    const bf16_t* vg = VT + ((size_t)((b * 8 + head) * 128 + vd)) * LP + vkc * 8;
    u32x4 kr[2], vr[2]; float br = 0.f;
#define ATT_GLOAD(KT) do { const int kbase_ = (KT) * 64; \
        kr[0] = *(const u32x4*)(kg + (size_t)kbase_ * 1024); kr[1] = *(const u32x4*)(kg + (size_t)(kbase_ + 32) * 1024); \
        vr[0] = *(const u32x4*)(vg + kbase_); vr[1] = *(const u32x4*)(vg + (size_t)64 * LP + kbase_); \
        if (t < 64) br = (NCK[kbase_ + t] + cref) * LOG2E; } while (0)
#define ATT_SWRITE(BI) do { unsigned char* sb_ = lds + (BI) * BUF; \
        *(u32x4*)(sb_ + kkey * 272 + kdc * 16) = kr[0]; *(u32x4*)(sb_ + (kkey + 32) * 272 + kdc * 16) = kr[1]; \
        *(u32x4*)(sb_ + VOFF + vd * 144 + vkc * 16) = vr[0]; *(u32x4*)(sb_ + VOFF + (vd + 64) * 144 + vkc * 16) = vr[1]; \
        if (t < 64) *(float*)(sb_ + BOFF + t * 4) = br; } while (0)
#define ATT_PV(SBV, PP) do { _Pragma("unroll") for (int kb_ = 0; kb_ < 2; ++kb_) _Pragma("unroll") for (int sp_ = 0; sp_ < 2; ++sp_) _Pragma("unroll") for (int db_ = 0; db_ < 4; ++db_) { \
        const unsigned char* va_ = (SBV) + VOFF + (32 * db_ + r) * 144 + (32 * kb_ + 16 * sp_ + 4 * hh) * 2; \
        o[db_] = MFMA(cat4(*(const s16x4*)va_, *(const s16x4*)(va_ + 16)), PP[kb_][sp_], o[db_]); } } while (0)
    float* WM = (float*)(lds + WMOFF);
    if (t < 16) WM[t] = -1e30f;
    ATT_GLOAD(kt_last); ATT_SWRITE(kt_last % 3);
    __syncthreads();
    const bool late = __builtin_amdgcn_readfirstlane(w) >= 4;
    bf16x8 pp[2][2]; bool pending = false; int pbuf = 0;
#pragma unroll 1
    for (int kt = kt_last; kt >= 1; --kt) {
        const int bi = kt % 3;
        const unsigned char* sb = lds + bi * BUF;
        {
            const f32x4 w0 = *(const f32x4*)(WM + ((kt + 1) & 1) * 8), w1 = *(const f32x4*)(WM + ((kt + 1) & 1) * 8 + 4);
            const float mfloor = fminf(fminf(fminf(w0.x, w0.y), fminf(w0.z, w0.w)), fminf(fminf(w1.x, w1.y), fminf(w1.z, w1.w)));
            const float blast = *(const float*)(sb + BOFF + 63 * 4);
            if (blast + qkb2 < mfloor - 32.f) break;
        }
        const bool more = kt > 1;
        if (more) ATT_GLOAD(kt - 1);
        if (pending) { ATT_PV(lds + pbuf * BUF, pp); pending = false; }
        float wmin = -1e30f;
        if (kt * 64 <= qw0 + 31) {
            f32x16 st[2];
#pragma unroll
            for (int kb = 0; kb < 2; ++kb) {
                st[kb] = zero16();
#pragma unroll
                for (int s = 0; s < 8; ++s) {
                    const bf16x8 a = *(const bf16x8*)(sb + (32 * kb + r) * 272 + (16 * s + 8 * hh) * 2);
                    st[kb] = MFMA(a, qf[s], st[kb]);
                }
            }
            const bool need_mask = (kt * 64 + 63 > qw0);
            float mx = -1e30f;
#pragma unroll
            for (int kb = 0; kb < 2; ++kb)
#pragma unroll
                for (int g = 0; g < 4; ++g) {
                    const f32x4 bz = *(const f32x4*)(sb + BOFF + (32 * kb + 8 * g + 4 * hh) * 4);
#pragma unroll
                    for (int e = 0; e < 4; ++e) {
                        float v = st[kb][4 * g + e] * ATT_SC + bz[e];
                        if (need_mask) { const int key = kt * 64 + 32 * kb + 8 * g + 4 * hh + e; v = (key > myq) ? -1e30f : v; }
                        st[kb][4 * g + e] = v; mx = fmaxf(mx, v);
                    }
                }
            mx = fmaxf(mx, __shfl_xor(mx, 32));
            const float m_new = fmaxf(m_run, mx);
            const bool grew = __builtin_amdgcn_ballot_w64(m_new > m_run) != 0ull;
            float ps = 0.f;
#pragma unroll
            for (int kb = 0; kb < 2; ++kb)
#pragma unroll
                for (int i = 0; i < 16; ++i) { const float pv = ex2(st[kb][i] - m_new); st[kb][i] = pv; ps += pv; }
            if (grew) {
                const float alpha = ex2(m_run - m_new); m_run = m_new;
                l_run = l_run * alpha;
#pragma unroll
                for (int db = 0; db < 4; ++db) o[db] = o[db] * alpha;
            }
            l_run += ps;
#pragma unroll
            for (int kb = 0; kb < 2; ++kb)
#pragma unroll
                for (int sp = 0; sp < 2; ++sp) pp[kb][sp] = pack8(st[kb], sp);
            if (late) { pending = true; pbuf = bi; }
            else ATT_PV(sb, pp);
            wmin = m_run;
#pragma unroll
            for (int of = 1; of < 32; of <<= 1) wmin = fminf(wmin, __shfl_xor(wmin, of));
        }
        if (lane == 0) WM[(kt & 1) * 8 + w] = wmin;
        if (more) ATT_SWRITE((kt - 1) % 3);
        __syncthreads();
    }
    if (pending) ATT_PV(lds + pbuf * BUF, pp);
#undef ATT_GLOAD
#undef ATT_SWRITE
#undef ATT_PV
    const float lt = l_run + __shfl_xor(l_run, 32);
    const float inv = frcp(lt);
#pragma unroll
    for (int db = 0; db < 4; ++db)
#pragma unroll
        for (int g = 0; g < 4; ++g) {
            u32x2 ov; ov.x = pk2(o[db][4 * g] * inv, o[db][4 * g + 1] * inv); ov.y = pk2(o[db][4 * g + 2] * inv, o[db][4 * g + 3] * inv);
            *(u32x2*)(qp + 32 * db + 8 * g + 4 * hh) = ov;
        }
}

DI void attn_sample_item(const Params& P, unsigned char* lds, int sb, int head) {
    const int t = opaque_tid(), w = t >> 6, lane = t & 63, r = lane & 31, hh = lane >> 5;
    bf16_t* FQ = (bf16_t*)(P.ws + WS_FQ);
    const float* NCK = (const float*)(P.ws + WS_NCKS) + (size_t)(sb * 8 + head) * 4128;
    const float cref = -NCK[4096];
    bf16_t* qrow = FQ + ((size_t)MPR + sb * 32) * 1024 + head * 128;
    bf16x8 qf[8];
#pragma unroll
    for (int s = 0; s < 8; ++s) qf[s] = *(const bf16x8*)(qrow + (size_t)r * 1024 + 16 * s + 8 * hh);
    f32x16 o[4];
#pragma unroll
    for (int db = 0; db < 4; ++db) o[db] = zero16();
    float m_run = -1e30f, l_run = 0.f;
#pragma unroll 1
    for (int tile = w; tile < 129; tile += 8) {
        const float *kbase, *vbase;
        if (tile < 128) { const size_t off = ((size_t)sb * 4096 + 32 * tile) * 1024 + head * 128; kbase = P.cache_k + off; vbase = P.cache_v + off; }
        else { const size_t off = (size_t)sb * 32 * 1024 + head * 128; kbase = P.out + O_SK + off; vbase = P.out + O_SV + off; }
        f32x16 st = zero16();
#pragma unroll
        for (int s = 0; s < 8; ++s) {
            const float* kp = kbase + (size_t)r * 1024 + 16 * s + 8 * hh;
            const f32x4 k0 = *(const f32x4*)kp, k1 = *(const f32x4*)(kp + 4);
            u32x4 pk; pk.x = pk2(k0.x, k0.y); pk.y = pk2(k0.z, k0.w); pk.z = pk2(k1.x, k1.y); pk.w = pk2(k1.z, k1.w);
            st = MFMA(__builtin_bit_cast(bf16x8, pk), qf[s], st);
        }
        float mx = -1e30f;
#pragma unroll
        for (int g = 0; g < 4; ++g) {
            const f32x4 bz = *(const f32x4*)(NCK + 32 * tile + 8 * g + 4 * hh);
#pragma unroll
            for (int e = 0; e < 4; ++e) {
                float v = st[4 * g + e] * ATT_SC + (bz[e] + cref) * LOG2E;
                if (tile == 128) { const int key = 8 * g + 4 * hh + e; v = (key > r) ? -1e30f : v; }
                st[4 * g + e] = v; mx = fmaxf(mx, v);
            }
        }
        mx = fmaxf(mx, __shfl_xor(mx, 32));
        const float m_new = fmaxf(m_run, mx);
        const float alpha = ex2(m_run - m_new); m_run = m_new;
        float ps = 0.f;
#pragma unroll
        for (int i = 0; i < 16; ++i) { const float pv = ex2(st[i] - m_new); st[i] = pv; ps += pv; }
        l_run = l_run * alpha + ps;
#pragma unroll
        for (int db = 0; db < 4; ++db) o[db] = o[db] * alpha;
#pragma unroll
        for (int sp = 0; sp < 2; ++sp) {
            const bf16x8 pb = pack8(st, sp);
#pragma unroll
            for (int db = 0; db < 4; ++db) {
                const float* vp = vbase + (size_t)(16 * sp + 4 * hh) * 1024 + 32 * db + r;
                float f[8];
#pragma unroll
                for (int j = 0; j < 8; ++j) f[j] = vp[(size_t)((j & 3) + 8 * (j >> 2)) * 1024];
                u32x4 pk; pk.x = pk2(f[0], f[1]); pk.y = pk2(f[2], f[3]); pk.z = pk2(f[4], f[5]); pk.w = pk2(f[6], f[7]);
                o[db] = MFMA(__builtin_bit_cast(bf16x8, pk), pb, o[db]);
            }
        }
    }
    const float lt = l_run + __shfl_xor(l_run, 32);
    float* Ol = (float*)lds; float* ML = (float*)(lds + 131072);
#pragma unroll
    for (int db = 0; db < 4; ++db)
#pragma unroll
        for (int i = 0; i < 16; ++i) Ol[(w * 128 + 32 * db + crow(i, hh)) * 32 + r] = o[db][i];
    if (hh == 0) { ML[(w * 32 + r) * 2] = m_run; ML[(w * 32 + r) * 2 + 1] = lt; }
    __syncthreads();
    {
        const int q = t & 31, dg = t >> 5;
        float M = -1e30f;
#pragma unroll
        for (int ww = 0; ww < 8; ++ww) M = fmaxf(M, ML[(ww * 32 + q) * 2]);
        float L = 0.f, a[8];
#pragma unroll
        for (int e = 0; e < 8; ++e) a[e] = 0.f;
#pragma unroll
        for (int ww = 0; ww < 8; ++ww) {
            const float f = ex2(ML[(ww * 32 + q) * 2] - M); L += ML[(ww * 32 + q) * 2 + 1] * f;
#pragma unroll
            for (int e = 0; e < 8; ++e) a[e] += Ol[(ww * 128 + dg * 8 + e) * 32 + q] * f;
        }
        const float inv = frcp(L);
        u32x4 ov; ov.x = pk2(a[0] * inv, a[1] * inv); ov.y = pk2(a[2] * inv, a[3] * inv); ov.z = pk2(a[4] * inv, a[5] * inv); ov.w = pk2(a[6] * inv, a[7] * inv);
        *(u32x4*)(qrow + (size_t)q * 1024 + dg * 8) = ov;
    }
    __syncthreads();
}

DI void phase_p3(const Params& P, unsigned char* lds) {
    constexpr int N_RETP = 208, N_RETS = 32, N_AS = 64, N_AP = 1024;
    constexpr int NITEMS = N_RETP + N_RETS + N_AS + N_AP;
    int* s_item = (int*)(lds + LDS_BYTES - 16);
    unsigned* ctr = (unsigned*)(P.ws + WS_CTL);
    float qkb2;
    {
        const int lane = threadIdx.x & 63;
        float gq = fmaxf(fabsf(P.q_norm_g[lane]), fabsf(P.q_norm_g[lane + 64])), gk = fmaxf(fabsf(P.k_norm_g[lane]), fabsf(P.k_norm_g[lane + 64]));
#pragma unroll
        for (int o = 1; o < 64; o <<= 1) { gq = fmaxf(gq, __shfl_xor(gq, o)); gk = fmaxf(gk, __shfl_xor(gk, o)); }
        qkb2 = 128.f * gq * gk * 1.02f * ATT_SC;
    }
    for (;;) {
        if (threadIdx.x == 0) *s_item = (int)atomicAdd(ctr, 1u);
        __syncthreads();
        int it = *s_item;
        __syncthreads();
        if (it >= NITEMS) break;
        if (it < 256) { const int head = 7 - (it >> 7), rem = it & 127; attn_prompt_item(P, lds, rem & 3, head, 31 - (rem >> 2), qkb2); continue; } it -= 256;
        if (it < N_RETP) { ret_passC_prompt(P, lds, it / 13, it % 13); continue; } it -= N_RETP;
        if (it < N_RETS) { ret_sample_item(P, lds, it >> 2, it & 3); continue; } it -= N_RETS;
        if (it < N_AS) { attn_sample_item(P, lds, it >> 3, it & 7); continue; } it -= N_AS;
        { const int head = 5 - (it >> 7), rem = it & 127; attn_prompt_item(P, lds, rem & 3, head, 31 - (rem >> 2), qkb2); }
    }
}

DI void light_grid_barrier(unsigned* ctl, unsigned seam) {
    asm volatile("s_waitcnt vmcnt(0)" ::: "memory");
    __syncthreads();
    if (threadIdx.x == 0) {
        const unsigned g = blockIdx.x & 7u, gs = (gridDim.x - g + 7u) >> 3, ng = gridDim.x < 8u ? gridDim.x : 8u;
        __builtin_amdgcn_fence(__ATOMIC_RELEASE, "agent");
        asm volatile("s_waitcnt vmcnt(0)" ::: "memory");
        const unsigned old = __hip_atomic_fetch_add(ctl + 64 + 32 * g, 1u, __ATOMIC_RELAXED, __HIP_MEMORY_SCOPE_AGENT);
        if (old == seam * gs + gs - 1u) {
            __builtin_amdgcn_fence(__ATOMIC_ACQ_REL, "agent");
            asm volatile("s_waitcnt vmcnt(0)" ::: "memory");
            const unsigned oldt = __hip_atomic_fetch_add(ctl + 32, 1u, __ATOMIC_RELAXED, __HIP_MEMORY_SCOPE_AGENT);
            if (oldt == seam * ng + ng - 1u) {
                __builtin_amdgcn_fence(__ATOMIC_ACQ_REL, "agent");
                asm volatile("s_waitcnt vmcnt(0)" ::: "memory");
                for (unsigned j = 0; j < ng; ++j) __hip_atomic_store(ctl + 320 + 32 * j, seam + 1u, __ATOMIC_RELAXED, __HIP_MEMORY_SCOPE_AGENT);
            }
        }
        while (__hip_atomic_load(ctl + 320 + 32 * g, __ATOMIC_RELAXED, __HIP_MEMORY_SCOPE_AGENT) < seam + 1u) __builtin_amdgcn_s_sleep(8);
        __builtin_amdgcn_fence(__ATOMIC_ACQUIRE, "agent");
        asm volatile("s_waitcnt vmcnt(0)" ::: "memory");
    }
    __syncthreads();
}

#define XB_TMO      128
#define XB_XCNT(j)  (256  + 64 * (j))
#define XB_XSUB(j)  (1280 + 64 * (j))
#define XB_XGEN(j)  (2304 + 64 * (j))
#define XB_TOP      3328
#define XB_TOPGEN   3392
#define XB_SPIN_CAP (1u << 18)
DI unsigned xb_ld(unsigned* p)              { return __hip_atomic_load(p, __ATOMIC_RELAXED, __HIP_MEMORY_SCOPE_AGENT); }
DI unsigned xb_add(unsigned* p, unsigned v) { return __hip_atomic_fetch_add(p, v, __ATOMIC_RELAXED, __HIP_MEMORY_SCOPE_AGENT); }
DI unsigned xb_xcc_id() { return (unsigned)__builtin_amdgcn_s_getreg((3 << 11) | 20) & 0xFu; }
#define XB_SPIN(cond, bar) do { unsigned _sp = 0; while (cond) { __builtin_amdgcn_s_sleep(1); \
    if ((++_sp & 255u) == 0u) { if (xb_ld(&(bar)[XB_TMO])) break; if (_sp > XB_SPIN_CAP) { atomicAdd(&(bar)[XB_TMO], 1u); break; } } } } while (0)
struct XcdBarrier { unsigned* bar; unsigned x; volatile AS_LDS unsigned* st; };
DI XcdBarrier xcd_barrier_post(unsigned* bar, volatile AS_LDS unsigned* st) {
    XcdBarrier b; b.bar = bar; b.x = xb_xcc_id(); b.st = st;
    if (threadIdx.x == 0) (void)xb_add(&bar[XB_XCNT(b.x)], 1u);
    return b;
}
DI void xcd_barrier_complete(unsigned* bar, unsigned x, unsigned& nloc, unsigned& nx) {
    const unsigned G = gridDim.x * gridDim.y * gridDim.z;
    unsigned sum, cnt, mine, sp = 0u;
    for (;;) {
        sum = 0u; cnt = 0u; mine = 0u;
#pragma unroll
        for (unsigned j = 0; j < 16; ++j) { const unsigned c = xb_ld(&bar[XB_XCNT(j)]); sum += c; cnt += (c > 0u) ? 1u : 0u; mine = (j == x) ? c : mine; }
        if (sum == G) break;
        __builtin_amdgcn_s_sleep(1);
        if ((++sp & 255u) == 0u) { if (xb_ld(&bar[XB_TMO])) break; if (sp > XB_SPIN_CAP) { atomicAdd(&bar[XB_TMO], 1u); break; } }
    }
    nloc = mine > 0u ? mine : 1u; nx = cnt > 0u ? cnt : 1u;
}
DI void xcd_barrier(const XcdBarrier& b) {
    asm volatile("s_waitcnt vmcnt(0)" ::: "memory");
    __syncthreads();
    if (threadIdx.x == 0) {
        unsigned* bar = b.bar;
        __builtin_amdgcn_s_waitcnt(0);
        unsigned nloc = b.st[0], nx = b.st[1];
        if (nloc == 0u) { xcd_barrier_complete(bar, b.x, nloc, nx); b.st[0] = nloc; b.st[1] = nx; }
        const unsigned old = xb_add(&bar[XB_XSUB(b.x)], 1u);
        const unsigned gen = old / nloc;
        if (old + 1u == (gen + 1u) * nloc) {
            __builtin_amdgcn_fence(__ATOMIC_RELEASE, "agent");
            asm volatile("s_waitcnt vmcnt(0)" ::: "memory");
            const unsigned og = xb_add(&bar[XB_TOP], 1u);
            const unsigned tg = og / nx;
            if (og + 1u == (tg + 1u) * nx) xb_add(&bar[XB_TOPGEN], 1u);
            else XB_SPIN(xb_ld(&bar[XB_TOPGEN]) == tg, bar);
            __builtin_amdgcn_fence(__ATOMIC_ACQUIRE, "agent");
            xb_add(&bar[XB_XGEN(b.x)], 1u);
            asm volatile("s_waitcnt vmcnt(0)" ::: "memory");
        } else {
            XB_SPIN(xb_ld(&bar[XB_XGEN(b.x)]) == gen, bar);
            __builtin_amdgcn_fence(__ATOMIC_ACQUIRE, "agent");
            asm volatile("s_waitcnt vmcnt(0)" ::: "memory");
        }
    }
    __syncthreads();
}

__global__ void __launch_bounds__(512) mega_fwd(Params P) {
    extern __shared__ __attribute__((aligned(16))) unsigned char lds[];
    cg::grid_group grid = cg::this_grid();
    volatile AS_LDS unsigned* xst = (volatile AS_LDS unsigned*)(lds + LDS_BYTES - 32);
    if (threadIdx.x < 2) xst[threadIdx.x] = 0u;
    __syncthreads();
    const XcdBarrier xb = xcd_barrier_post((unsigned*)(P.ws + WS_BAR), xst);
#define RUN_PHASE(K, BODY) do { if (P.ph_lo <= (K) && (K) < P.ph_hi) { BODY; if (P.coop && (K) + 1 < P.ph_hi) { if (P.pad) grid.sync();     xcd_barrier(xb); } } } while (0)
    RUN_PHASE(0, (p0_rows(P, lds), p0_weights(P, lds), p0_misc(P)));
    RUN_PHASE(1, phase_p1(P, lds));
    RUN_PHASE(2, phase_p2(P, lds));
    RUN_PHASE(3, phase_p3(P, lds));
    RUN_PHASE(4, phase_p4(P, lds));
    RUN_PHASE(5, phase_p5(P, lds));
    RUN_PHASE(6, phase_p6(P, lds));
    RUN_PHASE(7, phase_p7(P, lds));
#undef RUN_PHASE
}

extern "C" void kernel_launch(void* const* d_in, const int* in_sizes, int n_in, void* d_out, int out_size, void* d_ws, size_t ws_size, hipStream_t stream) {
    static int grid_blocks = 0;
    if (!grid_blocks) {
        int dev = 0, cus = 0, per_cu = 0;
        (void)hipGetDevice(&dev);
        (void)hipDeviceGetAttribute(&cus, hipDeviceAttributeMultiprocessorCount, dev);
        (void)hipFuncSetAttribute((const void*)mega_fwd, hipFuncAttributeMaxDynamicSharedMemorySize, LDS_BYTES);
        (void)hipOccupancyMaxActiveBlocksPerMultiprocessor(&per_cu, (const void*)mega_fwd, 512, LDS_BYTES);
        if (per_cu < 1) { fprintf(stderr, "kernel_launch: occupancy query returned %d\n", per_cu); per_cu = 1; }
        grid_blocks = cus * per_cu;
        if (ws_size < WS_END) fprintf(stderr, "kernel_launch: workspace too small: %zu < %zu\n", ws_size, (size_t)WS_END);
        (void)hipGetLastError();
    }
    Params p{};
    p.x_prompt = (const float*)d_in[0]; p.x_sample = (const float*)d_in[1]; p.state_ret = (const float*)d_in[2]; p.cache_k = (const float*)d_in[3];
    p.cache_v = (const float*)d_in[4]; p.cache_logf = (const float*)d_in[5]; p.meta = (const float*)d_in[6]; p.norm1_g = (const float*)d_in[7];
    p.w_in = (const float*)d_in[8]; p.b_forget = (const float*)d_in[9]; p.q_norm_g = (const float*)d_in[10]; p.k_norm_g = (const float*)d_in[11];
    p.ret_gn_g = (const float*)d_in[12]; p.w_ret_out = (const float*)d_in[13]; p.w_fox_out = (const float*)d_in[14]; p.w_o = (const float*)d_in[15];
    p.norm2_g = (const float*)d_in[16]; p.w_ff1 = (const float*)d_in[17]; p.w_ff2 = (const float*)d_in[18];
    p.out = (float*)d_out; p.ws = (unsigned char*)d_ws; p.pad = 0;
    (void)hipMemsetAsync((unsigned char*)d_ws + WS_CTL, 0, 4096 + 16384, stream);
#if MULTI_LAUNCH
    for (int ph = 0; ph < 8; ++ph) {
        p.ph_lo = ph; p.ph_hi = ph + 1; p.coop = 0;
        hipLaunchKernelGGL(mega_fwd, dim3(grid_blocks), dim3(512), LDS_BYTES, stream, p);
    }
#else
    p.ph_lo = 0; p.ph_hi = 8; p.coop = 1;
    void* args[] = {&p};
    hipError_t e = hipLaunchCooperativeKernel((void*)mega_fwd, dim3(grid_blocks), dim3(512), args, LDS_BYTES, stream);
    if (e != hipSuccess) fprintf(stderr, "cooperative launch failed: %s (grid %d)\n", hipGetErrorString(e), grid_blocks);
#endif
}
```
